# Optimizing an MI355X kernel written in HIP

```python
import jax, jax.numpy as jnp
from jax import lax
import numpy as np

D_MODEL = 1024
BATCH = 16
SEQ = 2048
DEPTH = 4

D_MIX = D_MODEL
D_FOURIER = D_MIX // 2
D_POOL = D_MIX - D_FOURIER
N_FOURIER_HEADS = 4
FOURIER_HEAD_DIM = D_FOURIER // N_FOURIER_HEADS
POOL_WINDOWS = (2, 4, 8, 16)
N_POOL_GROUPS = len(POOL_WINDOWS)
POOL_GROUP_DIM = D_POOL // N_POOL_GROUPS
D_FF = 128 * ((8 * D_MODEL // 3 + 127) // 128)
EPS = 1e-6

kernel_name = "hybrid_fourier_pool_macaron_encoder"


def rms_norm(x, g):
    xf = x.astype(jnp.float32)
    y = xf * lax.rsqrt(jnp.mean(xf * xf, axis=-1, keepdims=True) + EPS)
    return (y * g.astype(jnp.float32)).astype(x.dtype)


def swiglu(h, w_gate, w_up, w_down):
    a = jnp.einsum('bsd,df->bsf', h, w_gate)
    b = jnp.einsum('bsd,df->bsf', h, w_up)
    return jnp.einsum('bsf,fd->bsd', jax.nn.silu(a) * b, w_down)


def fourier_heads(u, w):
    B, S, _ = u.shape
    uh = u.reshape(B, S, N_FOURIER_HEADS, FOURIER_HEAD_DIM).astype(jnp.float32)
    f = jnp.fft.fft2(uh, axes=(1, 3), norm='ortho').real.astype(u.dtype)
    return jnp.einsum('bshc,hcd->bshd', f, w).reshape(B, S, D_FOURIER)


def centred_window_mean(u, radius):
    S = u.shape[1]
    cs = jnp.pad(jnp.cumsum(u, axis=1), ((0, 0), (1, 0), (0, 0)))
    cs = jnp.pad(cs, ((0, 0), (radius, radius), (0, 0)), mode='edge')
    win = cs[:, 2 * radius + 1:2 * radius + 1 + S] - cs[:, :S]
    t = jnp.arange(S)
    count = (jnp.minimum(t + radius, S - 1) - jnp.maximum(t - radius, 0) + 1).astype(jnp.float32)
    return win / count[None, :, None]


def pool_groups(u, w, scale):
    B, S, _ = u.shape
    uf = u.reshape(B, S, N_POOL_GROUPS, POOL_GROUP_DIM).astype(jnp.float32)
    diffs = jnp.stack(
        [centred_window_mean(uf[:, :, g], win // 2) - uf[:, :, g] for g, win in enumerate(POOL_WINDOWS)],
        axis=2).astype(u.dtype)
    y = jnp.einsum('bsgc,gcd->bsgd', diffs, w).reshape(B, S, D_POOL)
    return y * scale


def setup_inputs(seed: int = 0) -> dict:
    key = jax.random.key(seed)
    ks = jax.random.split(key, 24)

    def normal(k, shape, fan_in):
        return jax.random.normal(k, shape, jnp.float32) * (fan_in ** -0.5)

    def gain(k, shape):
        return 1.0 + 0.02 * jax.random.normal(k, shape, jnp.float32)

    L, D, F = DEPTH, D_MODEL, D_FF
    return {
        "x": jax.random.normal(ks[0], (BATCH, SEQ, D), jnp.float32),
        "ffn1_pre_g": gain(ks[1], (L, D)),
        "ffn1_w_gate": normal(ks[2], (L, D, F), D),
        "ffn1_w_up": normal(ks[3], (L, D, F), D),
        "ffn1_w_down": normal(ks[4], (L, F, D), F),
        "ffn1_post_g": gain(ks[5], (L, D)),
        "mix_pre_g": gain(ks[6], (L, D)),
        "w_in": normal(ks[7], (L, D, D_MIX), D),
        "fourier_w": normal(ks[8], (L, N_FOURIER_HEADS, FOURIER_HEAD_DIM, FOURIER_HEAD_DIM), FOURIER_HEAD_DIM),
        "pool_w": normal(ks[9], (L, N_POOL_GROUPS, POOL_GROUP_DIM, POOL_GROUP_DIM), POOL_GROUP_DIM),
        "pool_scale": gain(ks[10], (L, D_POOL)),
        "w_out": normal(ks[11], (L, D_MIX, D), D_MIX),
        "mix_post_g": gain(ks[12], (L, D)),
        "ffn2_pre_g": gain(ks[13], (L, D)),
        "ffn2_w_gate": normal(ks[14], (L, D, F), D),
        "ffn2_w_up": normal(ks[15], (L, D, F), D),
        "ffn2_w_down": normal(ks[16], (L, F, D), F),
        "ffn2_post_g": gain(ks[17], (L, D)),
    }


def reference(x, ffn1_pre_g, ffn1_w_gate, ffn1_w_up, ffn1_w_down, ffn1_post_g,
              mix_pre_g, w_in, fourier_w, pool_w, pool_scale, w_out, mix_post_g,
              ffn2_pre_g, ffn2_w_gate, ffn2_w_up, ffn2_w_down, ffn2_post_g):
    for l in range(DEPTH):
        h = rms_norm(x, ffn1_pre_g[l])
        x = x + 0.5 * rms_norm(swiglu(h, ffn1_w_gate[l], ffn1_w_up[l], ffn1_w_down[l]), ffn1_post_g[l])

        h = rms_norm(x, mix_pre_g[l])
        u = jnp.einsum('bsd,dm->bsm', h, w_in[l])
        y_fourier = fourier_heads(u[..., :D_FOURIER], fourier_w[l])
        y_pool = pool_groups(u[..., D_FOURIER:], pool_w[l], pool_scale[l])
        y = jnp.einsum('bsm,md->bsd', jnp.concatenate([y_fourier, y_pool], axis=-1), w_out[l])
        x = x + rms_norm(y, mix_post_g[l])

        h = rms_norm(x, ffn2_pre_g[l])
        x = x + 0.5 * rms_norm(swiglu(h, ffn2_w_gate[l], ffn2_w_up[l], ffn2_w_down[l]), ffn2_post_g[l])
    return x
```

```cpp
#include <hip/hip_runtime.h>
#include <hip/hip_cooperative_groups.h>
#include <cstdio>
#include <cstdint>
namespace cg = cooperative_groups;

#ifndef MULTI_LAUNCH
#define MULTI_LAUNCH 0
#endif

#define LAS __attribute__((address_space(3)))
typedef unsigned short bf16_t;
typedef short bf16x8 __attribute__((ext_vector_type(8)));
typedef float f32x4 __attribute__((ext_vector_type(4)));
typedef unsigned u32x4 __attribute__((ext_vector_type(4)));
typedef unsigned u32x2 __attribute__((ext_vector_type(2)));

__device__ __forceinline__ int tid_opaque() { int t; asm volatile("v_mov_b32 %0, %1" : "=v"(t) : "v"(threadIdx.x)); return t; }

constexpr int NTOK = 32768, DM = 1024, FF = 2816, NL = 4, SEQ = 2048, NB = 16;
constexpr float EPS = 1e-6f;
constexpr int NTHREADS = 512;
constexpr int LDS_BYTES = 131072;

constexpr size_t SZ_WGU = (size_t)NL * 2 * 5632 * 1024 * 2;
constexpr size_t SZ_WD = (size_t)NL * 2 * 1024 * 2816 * 2;
constexpr size_t SZ_WA = (size_t)NL * 1024 * 1024 * 2;
constexpr size_t SZ_WB = (size_t)NL * 512 * 1024 * 2;
constexpr size_t SZ_WO = (size_t)NL * 1024 * 1024 * 2;
constexpr size_t SZ_TM = (size_t)2048 * 4096 * 2;
constexpr size_t SZ_MCS = (size_t)NL * 4 * 128 * 256 * 4;
constexpr size_t SZ_H = (size_t)NTOK * 1024 * 2;
constexpr size_t SZ_Y = (size_t)NTOK * 1024 * 2;
constexpr size_t SZ_HID = (size_t)NTOK * 2816 * 2;
constexpr size_t OFF_WGU = 0;
constexpr size_t OFF_WD = OFF_WGU + SZ_WGU;
constexpr size_t OFF_WA = OFF_WD + SZ_WD;
constexpr size_t OFF_WB = OFF_WA + SZ_WA;
constexpr size_t OFF_WO = OFF_WB + SZ_WB;
constexpr size_t OFF_TM = OFF_WO + SZ_WO;
constexpr size_t OFF_MCS = OFF_TM + SZ_TM;
constexpr size_t OFF_H = OFF_MCS + SZ_MCS;
constexpr size_t OFF_Y = OFF_H + SZ_H;
constexpr size_t OFF_HID = OFF_Y + SZ_Y;
constexpr size_t OFF_PT = OFF_HID;
constexpr size_t SZ_PT = (size_t)NB * 512 * 4096 * 2;
constexpr size_t OFF_Q = OFF_PT + SZ_PT;
constexpr size_t SZ_Q = (size_t)NTOK * 512 * 2;
constexpr size_t OFF_YCAT = OFF_Q + SZ_Q;
constexpr size_t SZ_YCAT = (size_t)NTOK * 1024 * 2;
constexpr size_t WS_END = OFF_HID + SZ_HID;
static_assert(OFF_YCAT + SZ_YCAT <= WS_END, "alias region");

struct Params { const float* in[18]; float* out; unsigned char* ws; int ph_lo, ph_hi; };

namespace pg8 {
constexpr int BM = 256, BK = 64, HALF = 128, HTB = HALF * BK * 2, STAGE_BYTES = 8 * HTB, NXCD = 8, WGM = 8;
__host__ __device__ __forceinline__ int lds_byte(int r, int c) { const int st = (r >> 4) * 2 + (c >> 5), rr = r & 15, cc = c & 31, ob = rr * 64 + cc * 2; return st * 1024 + (ob ^ (((ob >> 9) & 1) << 5)); }
__host__ __device__ __forceinline__ void stage_rc(int b, int& R, int& C) { const int st = b / 1024, sb = b % 1024, swz = sb ^ (((sb >> 9) & 1) << 5); R = (st >> 1) * 16 + swz / 64; C = (st & 1) * 32 + (swz % 64) / 2; }
__host__ __device__ __forceinline__ int perm32(int rho) { const int n = rho >> 4, i = rho & 15; return 8 * (i >> 2) + 4 * n + (i & 3); }

struct Unit { int pm, pn; };
struct Gemm { const bf16_t* A; const bf16_t* Bt; int M, N, K; };

struct Order {
    int nM, nN, nwg, G, c, mode;
    __device__ void init(int M, int N, int G_, int c_, int mode_) { nM = M / BM; nN = N / BM; nwg = nM * nN; G = G_; c = c_; mode = mode_; }
    __device__ bool next(int i, Unit& u) const {
        const long L = (long)i * G + c; if (L >= nwg) return false;
        if (mode == 1) { const int xcd = (int)L & 7, j = (int)L >> 3; const int b = 2 * xcd + (j >> 4); u.pn = b * 2 + ((j >> 3) & 1); u.pm = j & 7; return true; }
        int wgid = (int)L; { const int q = nwg / NXCD, r = nwg % NXCD, xcd = wgid % NXCD, off = wgid / NXCD; wgid = (xcd < r ? xcd * (q + 1) : r * (q + 1) + (xcd - r) * q) + off; }
        const int nig = WGM * nN, gid = wgid / nig, fm = gid * WGM, gsz = (nM - fm) < WGM ? (nM - fm) : WGM;
        u.pm = fm + ((wgid % nig) % gsz); u.pn = (wgid % nig) / gsz; return true;
    }
    __device__ __forceinline__ void a_ready(const Unit&) const {}
    __device__ __forceinline__ void done(const Unit&) const {}
};

__device__ __forceinline__ unsigned cvt_pk_bf16(float lo, float hi) { unsigned r; asm volatile("v_cvt_pk_bf16_f32 %0, %1, %2" : "=v"(r) : "v"(lo), "v"(hi)); return r; }

struct EpiMap {
    static constexpr bool PERM = true, AFTER_DRAIN = false;
    bf16_t* O; int ldc; int mode;
    __device__ __forceinline__ void operator()(const f32x4 (&acc)[2][2][4][2], const Unit& u, int wr, int wc, int fr, int fq) const {
        size_t tb; int ld = ldc;
        if (mode == 0) tb = (size_t)u.pm * 256 * (size_t)ldc + (size_t)u.pn * 256;
        else if (mode == 1) { tb = ((size_t)((u.pn >> 3) * 512 + (u.pm & 1) * 256)) * 4096 + (size_t)((u.pm >> 1) * 2048 + (u.pn & 7) * 256); ld = 4096; }
        else { tb = ((size_t)((u.pn >> 1) * 2048 + u.pm * 256)) * 1024 + (size_t)((u.pn & 1) * 256); ld = 1024; }
        bf16_t* base = O + tb + (size_t)(wr * 64 + fr) * ld + wc * 32 + 8 * fq;
#pragma unroll
        for (int ai = 0; ai < 2; ++ai)
#pragma unroll
            for (int m = 0; m < 4; ++m) { bf16_t* rowp = base + (size_t)(ai * HALF + m * 16) * ld;
#pragma unroll
                for (int bj = 0; bj < 2; ++bj) { const f32x4 v0 = acc[ai][bj][m][0], v1 = acc[ai][bj][m][1];
                    u32x4 w; w.x = cvt_pk_bf16(v0[0], v0[1]); w.y = cvt_pk_bf16(v0[2], v0[3]); w.z = cvt_pk_bf16(v1[0], v1[1]); w.w = cvt_pk_bf16(v1[2], v1[3]);
                    *(u32x4*)(rowp + bj * HALF) = w; } }
    }
};
__device__ __forceinline__ float silu_mul(float a, float b) { return a * __builtin_amdgcn_rcpf(1.0f + __expf(-a)) * b; }
struct EpiSwiGLU {
    static constexpr bool PERM = true, AFTER_DRAIN = false;
    bf16_t* O;
    __device__ __forceinline__ void operator()(const f32x4 (&acc)[2][2][4][2], const Unit& u, int wr, int wc, int fr, int fq) const {
        bf16_t* base = O + (size_t)(u.pm * 256 + wr * 64 + fr) * FF + u.pn * 128 + wc * 32 + 8 * fq;
#pragma unroll
        for (int ai = 0; ai < 2; ++ai)
#pragma unroll
            for (int m = 0; m < 4; ++m) { bf16_t* rowp = base + (size_t)(ai * HALF + m * 16) * FF;
                const f32x4 g0 = acc[ai][0][m][0], g1 = acc[ai][0][m][1], u0 = acc[ai][1][m][0], u1 = acc[ai][1][m][1];
                u32x4 w; w.x = cvt_pk_bf16(silu_mul(g0[0], u0[0]), silu_mul(g0[1], u0[1])); w.y = cvt_pk_bf16(silu_mul(g0[2], u0[2]), silu_mul(g0[3], u0[3]));
                w.z = cvt_pk_bf16(silu_mul(g1[0], u1[0]), silu_mul(g1[1], u1[1])); w.w = cvt_pk_bf16(silu_mul(g1[2], u1[2]), silu_mul(g1[3], u1[3]));
                *(u32x4*)rowp = w; }
    }
};

template <class Epi, class Sched, bool ALIGN_EPI = false, bool SP2 = false>
__device__ __forceinline__ void gemm_phase(LAS unsigned char* lds, const Gemm g, const Sched& S, const Epi& E) {
    const int tid = tid_opaque(), wid = __builtin_amdgcn_readfirstlane(tid >> 6), lane = tid & 63, wr = wid >> 2, wc = wid & 3, fr = lane & 15, fq = lane >> 4;
    const int K = g.K, nt = K / BK;
    unsigned voffA[2], voffB[2];
#pragma unroll
    for (int i = 0; i < 2; ++i) { int R, C; stage_rc(tid * 16 + i * 8192, R, C); const int Rb = Epi::PERM ? ((R & ~31) + perm32(R & 31)) : R;
        voffA[i] = (unsigned)(R * K + C) * 2u; voffB[i] = (unsigned)(Rb * K + C) * 2u; }
    const size_t kstep = (size_t)(BK * 2);
    const size_t hstep = (size_t)HALF * K * 2;
    const size_t tstep = 2 * hstep;
    const unsigned ldsw = (unsigned)wid * 1024u;
    const int aoff = lds_byte(wr * 64 + fr, fq * 8), boff = lds_byte(wc * 32 + fr, fq * 8);
#define PG8_SA(b, h) (((b) * 2 + (h)) * HTB)
#define PG8_SB(b, h) ((4 + (b) * 2 + (h)) * HTB)
#define PG8_STAGE(bufoff, gbase, voff) do { _Pragma("unroll") for (int _i = 0; _i < 2; ++_i) \
        __builtin_amdgcn_global_load_lds((const unsigned*)((const char*)(gbase) + (voff)[_i]), (LAS unsigned*)(lds + (bufoff) + ldsw + _i * 8192), 16, 0, 0); } while (0)
#define PG8_LDA(dst, b, h) do { _Pragma("unroll") for (int m = 0; m < 4; ++m) _Pragma("unroll") for (int k = 0; k < 2; ++k) dst[m][k] = *(const LAS bf16x8*)(lds + PG8_SA(b, h) + aoff + m * 2048 + k * 1024); } while (0)
#define PG8_LDB(dst, b, h) do { _Pragma("unroll") for (int n = 0; n < 2; ++n) _Pragma("unroll") for (int k = 0; k < 2; ++k) dst[n][k] = *(const LAS bf16x8*)(lds + PG8_SB(b, h) + boff + n * 2048 + k * 1024); } while (0)
#define PG8_MMA(ai, bj, At, Bt) do { __builtin_amdgcn_s_setprio(1); _Pragma("unroll") for (int m = 0; m < 4; ++m) _Pragma("unroll") for (int n = 0; n < 2; ++n) _Pragma("unroll") for (int k = 0; k < 2; ++k) \
        acc[ai][bj][m][n] = __builtin_amdgcn_mfma_f32_16x16x32_bf16(Bt[n][k], At[m][k], acc[ai][bj][m][n], 0, 0, 0); __builtin_amdgcn_s_setprio(0); } while (0)
#define PG8_WAIT_V(n) asm volatile("s_waitcnt vmcnt(" #n ")" ::: "memory")
#define PG8_WAIT_L(n) asm volatile("s_waitcnt lgkmcnt(" #n ")" ::: "memory")
#define PG8_BAR __builtin_amdgcn_s_barrier()
#define PG8_SCHED __builtin_amdgcn_sched_barrier(0)
    Unit cur, nxt; int ui = 0;
    if (!S.next(0, cur)) return;
    f32x4 acc[2][2][4][2];
#pragma unroll
    for (int a = 0; a < 2; ++a)
#pragma unroll
        for (int b = 0; b < 2; ++b)
#pragma unroll
            for (int m = 0; m < 4; ++m)
#pragma unroll
                for (int n = 0; n < 2; ++n) acc[a][b][m][n] = (f32x4){0.f, 0.f, 0.f, 0.f};
    bf16x8 At[4][2], B0[2][2], B1[2][2];
    const char* cA = (const char*)g.A + (size_t)cur.pm * tstep; const char* cB = (const char*)g.Bt + (size_t)cur.pn * tstep;
    S.a_ready(cur);
    if constexpr (SP2) {
        PG8_STAGE(PG8_SB(0, 0), cB, voffB); PG8_STAGE(PG8_SB(0, 1), cB + hstep, voffB); PG8_STAGE(PG8_SA(0, 0), cA, voffA); PG8_STAGE(PG8_SA(0, 1), cA + hstep, voffA);
        if (wr == 1) PG8_BAR;
        PG8_WAIT_V(2); PG8_BAR;
        PG8_STAGE(PG8_SB(1, 0), cB + kstep, voffB); PG8_STAGE(PG8_SA(1, 0), cA + kstep, voffA); PG8_STAGE(PG8_SB(1, 1), cB + hstep + kstep, voffB);
        PG8_WAIT_V(6); PG8_BAR;
    } else {
        PG8_STAGE(PG8_SB(0, 0), cB, voffB); PG8_STAGE(PG8_SA(0, 0), cA, voffA); PG8_STAGE(PG8_SB(0, 1), cB + hstep, voffB); PG8_STAGE(PG8_SA(0, 1), cA + hstep, voffA);
        if (wr == 1) PG8_BAR;
        PG8_WAIT_V(4); PG8_BAR;
        PG8_STAGE(PG8_SB(1, 0), cB + kstep, voffB); PG8_STAGE(PG8_SA(1, 0), cA + kstep, voffA); PG8_STAGE(PG8_SB(1, 1), cB + hstep + kstep, voffB);
        PG8_WAIT_V(6); PG8_BAR;
    }
    for (;;) {
        const bool has_next = S.next(ui + 1, nxt);
        const char* nA = has_next ? (const char*)g.A + (size_t)nxt.pm * tstep : cA; const char* nB = has_next ? (const char*)g.Bt + (size_t)nxt.pn * tstep : cB;
        for (int t = 0; t < nt; t += 2) {
            const bool last = (t == nt - 2);
            const char* a1 = cA + (size_t)(t + 1) * kstep;
            const char* a2 = last ? nA : cA + (size_t)(t + 2) * kstep; const char* b2 = last ? nB : cB + (size_t)(t + 2) * kstep;
            const char* a3 = a2 + kstep; const char* b3 = b2 + kstep;
            if (last && has_next) S.a_ready(nxt);
            if constexpr (SP2) {
            PG8_LDB(B0, 0, 0); PG8_LDB(B1, 0, 1); PG8_SCHED; PG8_LDA(At, 0, 0); PG8_STAGE(PG8_SA(1, 1), a1 + hstep, voffA);
            PG8_WAIT_V(8); PG8_WAIT_L(0); PG8_BAR; PG8_MMA(0, 0, At, B0); PG8_MMA(0, 1, At, B1); PG8_BAR; PG8_SCHED;
            PG8_LDA(At, 0, 1); PG8_STAGE(PG8_SB(0, 0), b2, voffB); PG8_STAGE(PG8_SB(0, 1), b2 + hstep, voffB); PG8_STAGE(PG8_SA(0, 0), a2, voffA);
            PG8_WAIT_V(8); PG8_WAIT_L(0); PG8_BAR; PG8_MMA(1, 0, At, B0); PG8_MMA(1, 1, At, B1); PG8_BAR; PG8_SCHED;
            PG8_LDB(B0, 1, 0); PG8_LDB(B1, 1, 1); PG8_SCHED; PG8_LDA(At, 1, 0); PG8_STAGE(PG8_SA(0, 1), a2 + hstep, voffA);
            PG8_WAIT_V(8); PG8_WAIT_L(0); PG8_BAR; PG8_MMA(0, 0, At, B0); PG8_MMA(0, 1, At, B1); PG8_BAR; PG8_SCHED;
            PG8_LDA(At, 1, 1); PG8_STAGE(PG8_SB(1, 0), b3, voffB); PG8_STAGE(PG8_SB(1, 1), b3 + hstep, voffB); PG8_STAGE(PG8_SA(1, 0), a3, voffA);
            PG8_WAIT_V(8); PG8_WAIT_L(0); PG8_BAR; PG8_MMA(1, 0, At, B0); PG8_MMA(1, 1, At, B1); PG8_BAR; PG8_SCHED;
            } else {
            PG8_LDB(B0, 0, 0); PG8_SCHED; PG8_LDA(At, 0, 0); PG8_STAGE(PG8_SA(1, 1), a1 + hstep, voffA);
            PG8_WAIT_L(8); PG8_BAR; PG8_WAIT_L(0); PG8_MMA(0, 0, At, B0); PG8_BAR; PG8_SCHED;
            PG8_LDB(B1, 0, 1); PG8_STAGE(PG8_SB(0, 0), b2, voffB);
            PG8_BAR; PG8_WAIT_L(0); PG8_MMA(0, 1, At, B1); PG8_BAR;
            PG8_LDA(At, 0, 1); PG8_STAGE(PG8_SA(0, 0), a2, voffA);
            PG8_BAR; PG8_WAIT_L(0); PG8_MMA(1, 0, At, B0); PG8_BAR; PG8_SCHED;
            PG8_STAGE(PG8_SB(0, 1), b2 + hstep, voffB);
            PG8_WAIT_V(6); PG8_BAR; PG8_MMA(1, 1, At, B1); PG8_BAR;
            PG8_LDB(B0, 1, 0); PG8_SCHED; PG8_LDA(At, 1, 0); PG8_STAGE(PG8_SA(0, 1), a2 + hstep, voffA);
            PG8_WAIT_L(8); PG8_BAR; PG8_WAIT_L(0); PG8_MMA(0, 0, At, B0); PG8_BAR; PG8_SCHED;
            PG8_LDB(B1, 1, 1); PG8_STAGE(PG8_SB(1, 0), b3, voffB);
            PG8_BAR; PG8_WAIT_L(0); PG8_MMA(0, 1, At, B1); PG8_BAR;
            PG8_LDA(At, 1, 1); PG8_STAGE(PG8_SA(1, 0), a3, voffA);
            PG8_BAR; PG8_WAIT_L(0); PG8_MMA(1, 0, At, B0); PG8_BAR; PG8_SCHED;
            PG8_STAGE(PG8_SB(1, 1), b3 + hstep, voffB);
            PG8_WAIT_V(6); PG8_BAR; PG8_MMA(1, 1, At, B1); PG8_BAR;
            }
        }
        if constexpr (ALIGN_EPI) { if (wr == 0) PG8_BAR; }
        if constexpr (!Epi::AFTER_DRAIN) { E(acc, cur, wr, wc, fr, fq); S.done(cur); }
        if (!has_next) break;
#pragma unroll
        for (int a = 0; a < 2; ++a)
#pragma unroll
            for (int b = 0; b < 2; ++b)
#pragma unroll
                for (int m = 0; m < 4; ++m)
#pragma unroll
                    for (int n = 0; n < 2; ++n) acc[a][b][m][n] = (f32x4){0.f, 0.f, 0.f, 0.f};
        cur = nxt; cA = nA; cB = nB; ++ui;
        if constexpr (ALIGN_EPI) { if (wr == 1) PG8_BAR; }
    }
    PG8_WAIT_V(0);
    if constexpr (!ALIGN_EPI) { if (wr == 0) PG8_BAR; }
    PG8_BAR;
#undef PG8_SA
#undef PG8_SB
#undef PG8_STAGE
#undef PG8_LDA
#undef PG8_LDB
#undef PG8_MMA
#undef PG8_WAIT_V
#undef PG8_WAIT_L
#undef PG8_BAR
#undef PG8_SCHED
}
}

__device__ __forceinline__ float wave_sum(float v) {
    v += __shfl_xor(v, 32); v += __shfl_xor(v, 16); v += __shfl_xor(v, 8); v += __shfl_xor(v, 4); v += __shfl_xor(v, 2); v += __shfl_xor(v, 1); return v;
}
__device__ __forceinline__ float bf_lo(unsigned u) { return __uint_as_float(u << 16); }
__device__ __forceinline__ float bf_hi(unsigned u) { return __uint_as_float(u & 0xffff0000u); }

__device__ __forceinline__ void norm_phase(const bf16_t* y, const float* xin, float* xout, bf16_t* h, const float* gpost, const float* gpre, float coef, int G) {
    const int tid = tid_opaque(); const int lane = tid & 63, wid = tid >> 6;
    const int gw = blockIdx.x * 8 + wid, nw = G * 8;
    const bool has_y = (y != nullptr), has_h = (h != nullptr);
    f32x4 gp[4], gq[4];
#pragma unroll
    for (int j = 0; j < 4; ++j) {
        gp[j] = has_y ? *(const f32x4*)(gpost + lane * 4 + 256 * j) : (f32x4){0.f, 0.f, 0.f, 0.f};
        gq[j] = has_h ? *(const f32x4*)(gpre + lane * 4 + 256 * j) : (f32x4){0.f, 0.f, 0.f, 0.f};
    }
    for (int row = gw; row < NTOK; row += 2 * nw) {
        const int r1 = row + nw; const bool ok1 = r1 < NTOK;
        const size_t o0 = (size_t)row * DM + lane * 4, o1 = (size_t)(ok1 ? r1 : row) * DM + lane * 4;
        f32x4 x0[4], x1[4]; u32x2 y0[4], y1[4];
#pragma unroll
        for (int j = 0; j < 4; ++j) { x0[j] = *(const f32x4*)(xin + o0 + 256 * j); x1[j] = *(const f32x4*)(xin + o1 + 256 * j); }
        if (has_y) {
#pragma unroll
            for (int j = 0; j < 4; ++j) { y0[j] = *(const u32x2*)(y + o0 + 256 * j); y1[j] = *(const u32x2*)(y + o1 + 256 * j); }
            f32x4 v0[4], v1[4]; float s0 = 0.f, s1 = 0.f;
#pragma unroll
            for (int j = 0; j < 4; ++j) {
                v0[j] = (f32x4){bf_lo(y0[j].x), bf_hi(y0[j].x), bf_lo(y0[j].y), bf_hi(y0[j].y)};
                v1[j] = (f32x4){bf_lo(y1[j].x), bf_hi(y1[j].x), bf_lo(y1[j].y), bf_hi(y1[j].y)};
                s0 += (v0[j][0] * v0[j][0] + v0[j][1] * v0[j][1]) + (v0[j][2] * v0[j][2] + v0[j][3] * v0[j][3]);
                s1 += (v1[j][0] * v1[j][0] + v1[j][1] * v1[j][1]) + (v1[j][2] * v1[j][2] + v1[j][3] * v1[j][3]);
            }
            s0 = wave_sum(s0); s1 = wave_sum(s1);
            const float c0 = coef * rsqrtf(s0 * (1.0f / DM) + EPS), c1 = coef * rsqrtf(s1 * (1.0f / DM) + EPS);
#pragma unroll
            for (int j = 0; j < 4; ++j) { x0[j] += v0[j] * gp[j] * c0; x1[j] += v1[j] * gp[j] * c1; }
        }
#pragma unroll
        for (int j = 0; j < 4; ++j) { *(f32x4*)(xout + o0 + 256 * j) = x0[j]; if (ok1) *(f32x4*)(xout + o1 + 256 * j) = x1[j]; }
        if (has_h) {
            float s0 = 0.f, s1 = 0.f;
#pragma unroll
            for (int j = 0; j < 4; ++j) {
                s0 += (x0[j][0] * x0[j][0] + x0[j][1] * x0[j][1]) + (x0[j][2] * x0[j][2] + x0[j][3] * x0[j][3]);
                s1 += (x1[j][0] * x1[j][0] + x1[j][1] * x1[j][1]) + (x1[j][2] * x1[j][2] + x1[j][3] * x1[j][3]);
            }
            s0 = wave_sum(s0); s1 = wave_sum(s1);
            const float c0 = rsqrtf(s0 * (1.0f / DM) + EPS), c1 = rsqrtf(s1 * (1.0f / DM) + EPS);
#pragma unroll
            for (int j = 0; j < 4; ++j) {
                const f32x4 a = x0[j] * gq[j] * c0, b = x1[j] * gq[j] * c1;
                u32x2 wa, wb; wa.x = pg8::cvt_pk_bf16(a[0], a[1]); wa.y = pg8::cvt_pk_bf16(a[2], a[3]); wb.x = pg8::cvt_pk_bf16(b[0], b[1]); wb.y = pg8::cvt_pk_bf16(b[2], b[3]);
                *(u32x2*)(h + o0 + 256 * j) = wa; if (ok1) *(u32x2*)(h + o1 + 256 * j) = wb;
            }
        }
    }
}

__device__ __forceinline__ void transpose_phase(const Params& p, LAS unsigned char* lds, int G) {
    LAS float* T = (LAS float*)lds;
    const int tid = tid_opaque();
    constexpr int TPL = 4480;
    const int nrounds = NL * TPL / 4;
    bf16_t* WGU = (bf16_t*)(p.ws + OFF_WGU); bf16_t* WD = (bf16_t*)(p.ws + OFF_WD); bf16_t* WO = (bf16_t*)(p.ws + OFF_WO);
    for (int R = blockIdx.x; R < nrounds; R += G) {
        const int ti0 = R * 4, l = ti0 / TPL, r = ti0 % TPL; int m = r / 704; if (m > 6) m = 6; const int t0 = r - m * 704;
        const float* src; int N, tn; bf16_t* dst; int ldd, kind;
        if (m == 0) { src = p.in[2] + (size_t)l * 1024 * 2816; N = 2816; tn = 44; dst = WGU + (size_t)(l * 2 + 0) * 5632 * 1024; ldd = 1024; kind = 0; }
        else if (m == 1) { src = p.in[3] + (size_t)l * 1024 * 2816; N = 2816; tn = 44; dst = WGU + (size_t)(l * 2 + 0) * 5632 * 1024; ldd = 1024; kind = 1; }
        else if (m == 2) { src = p.in[4] + (size_t)l * 2816 * 1024; N = 1024; tn = 16; dst = WD + (size_t)(l * 2 + 0) * 1024 * 2816; ldd = 2816; kind = 2; }
        else if (m == 3) { src = p.in[14] + (size_t)l * 1024 * 2816; N = 2816; tn = 44; dst = WGU + (size_t)(l * 2 + 1) * 5632 * 1024; ldd = 1024; kind = 0; }
        else if (m == 4) { src = p.in[15] + (size_t)l * 1024 * 2816; N = 2816; tn = 44; dst = WGU + (size_t)(l * 2 + 1) * 5632 * 1024; ldd = 1024; kind = 1; }
        else if (m == 5) { src = p.in[16] + (size_t)l * 2816 * 1024; N = 1024; tn = 16; dst = WD + (size_t)(l * 2 + 1) * 1024 * 2816; ldd = 2816; kind = 2; }
        else { src = p.in[11] + (size_t)l * 1024 * 1024; N = 1024; tn = 16; dst = WO + (size_t)l * 1024 * 1024; ldd = 1024; kind = 2; }
        f32x4 v[4][2];
#pragma unroll
        for (int q = 0; q < 4; ++q) { const int t = t0 + q, kt = t / tn, ntile = t - kt * tn;
#pragma unroll
            for (int i = 0; i < 2; ++i) v[q][i] = *(const f32x4*)(src + (size_t)(kt * 64 + (tid >> 4) + 32 * i) * N + ntile * 64 + (tid & 15) * 4); }
#pragma unroll
        for (int q = 0; q < 4; ++q)
#pragma unroll
            for (int i = 0; i < 2; ++i) { LAS float* d = T + q * 4160 + ((tid >> 4) + 32 * i) * 65 + (tid & 15) * 4; d[0] = v[q][i][0]; d[1] = v[q][i][1]; d[2] = v[q][i][2]; d[3] = v[q][i][3]; }
        __syncthreads();
#pragma unroll
        for (int q = 0; q < 4; ++q) { const int t = t0 + q, kt = t / tn, ntile = t - kt * tn;
            const int nl = tid >> 3, k8 = (tid & 7) * 8; const int n = ntile * 64 + nl;
            const int drow = (kind == 2) ? n : ((n >> 7) * 256 + (n & 127) + (kind == 1 ? 128 : 0));
            const LAS float* s = T + q * 4160 + k8 * 65 + nl;
            u32x4 w; w.x = pg8::cvt_pk_bf16(s[0], s[65]); w.y = pg8::cvt_pk_bf16(s[130], s[195]); w.z = pg8::cvt_pk_bf16(s[260], s[325]); w.w = pg8::cvt_pk_bf16(s[390], s[455]);
            *(u32x4*)(dst + (size_t)drow * ldd + kt * 64 + k8) = w; }
        __syncthreads();
    }
}

__device__ __forceinline__ void tm_phase(const Params& p, int G) {
    bf16_t* TM = (bf16_t*)(p.ws + OFF_TM);
    const int total = 2048 * 4096 / 8; const int tid = tid_opaque();
    for (int e = blockIdx.x * NTHREADS + tid; e < total; e += G * NTHREADS) {
        const int s = e >> 9, k0 = (e & 511) * 8; float v[8];
#pragma unroll
        for (int j = 0; j < 8; ++j) { const int k = k0 + j, kk = k & 2047; const int ph = (s * kk) & 2047; const float a = (float)ph * (1.0f / 1024.0f);
            v[j] = (k < 2048) ? cospif(a) * (1.0f / 512.0f) : -sinpif(a) * (1.0f / 512.0f); }
        u32x4 w; w.x = pg8::cvt_pk_bf16(v[0], v[1]); w.y = pg8::cvt_pk_bf16(v[2], v[3]); w.z = pg8::cvt_pk_bf16(v[4], v[5]); w.w = pg8::cvt_pk_bf16(v[6], v[7]);
        *(u32x4*)(TM + (size_t)e * 8) = w;
    }
}

__device__ __forceinline__ void mcs_phase(const Params& p, LAS unsigned char* lds, int G) {
    LAS float* tab = (LAS float*)lds;
    const int tid = tid_opaque();
    if (tid < 128) { const float a = (float)tid * (1.0f / 64.0f); tab[tid] = cospif(a); tab[128 + tid] = sinpif(a); }
    __syncthreads();
    float* MCS = (float*)(p.ws + OFF_MCS); const float* fw = p.in[8];
    const int total = NL * 4 * 128 * 256;
    for (int e = blockIdx.x * NTHREADS + tid; e < total; e += G * NTHREADS) {
        const int col = e & 255, c = (e >> 8) & 127, lh = e >> 15; const int part = col >> 7, d = col & 127;
        const float* w = fw + (size_t)lh * 128 * 128 + d; float acc = 0.f;
        for (int k = 0; k < 128; ++k) acc += tab[part * 128 + ((c * k) & 127)] * w[(size_t)k * 128];
        MCS[e] = acc;
    }
    __syncthreads();
}

__device__ __forceinline__ void fold_phase(const Params& p, LAS unsigned char* lds, int G) {
    LAS float* Wt = (LAS float*)lds;
    LAS float* Mt = (LAS float*)(lds + 64 * 132 * 4);
    const int tid = tid_opaque();
    const float* MCS = (const float*)(p.ws + OFF_MCS);
    bf16_t* WA = (bf16_t*)(p.ws + OFF_WA); bf16_t* WB = (bf16_t*)(p.ws + OFF_WB);
    const int nitems = NL * 24 * 16;
    for (int it = blockIdx.x; it < nitems; it += G) {
        const int kb = it & 15, ch = (it >> 4) % 24, l = (it >> 4) / 24;
        const float* win = p.in[7] + (size_t)l * 1024 * 1024;
        const float* msrc; int ldm, wcol; bf16_t* dst; const float* scl = nullptr;
        if (ch < 16) { const int h = ch >> 2, cc = ch & 3; msrc = MCS + (size_t)(l * 4 + h) * 128 * 256 + cc * 64; ldm = 256; wcol = h * 128;
            dst = WA + ((size_t)l * 1024 + (cc >> 1) * 512 + h * 128 + (cc & 1) * 64) * 1024; }
        else { const int g = (ch - 16) >> 1, d0 = ((ch - 16) & 1) * 64; msrc = p.in[9] + (size_t)(l * 4 + g) * 128 * 128 + d0; ldm = 128; wcol = 512 + g * 128;
            dst = WB + ((size_t)l * 512 + g * 128 + d0) * 1024; scl = p.in[10] + (size_t)l * 512 + g * 128 + d0; }
#pragma unroll
        for (int i = 0; i < 4; ++i) { const int kk = (tid >> 5) + 16 * i, c4 = (tid & 31) * 4;
            *(LAS f32x4*)(Wt + kk * 132 + c4) = *(const f32x4*)(win + (size_t)(kb * 64 + kk) * 1024 + wcol + c4); }
#pragma unroll
        for (int i = 0; i < 4; ++i) { const int c = (tid >> 4) + 32 * i, j4 = (tid & 15) * 4;
            f32x4 mv = *(const f32x4*)(msrc + (size_t)c * ldm + j4);
            if (scl) mv *= *(const f32x4*)(scl + j4);
            *(LAS f32x4*)(Mt + c * 64 + j4) = mv; }
        __syncthreads();
        const int j = tid & 63, k8 = (tid >> 6) * 8;
        float acc[8];
#pragma unroll
        for (int q = 0; q < 8; ++q) acc[q] = 0.f;
        for (int c4 = 0; c4 < 32; ++c4) {
            const float m0 = Mt[(c4 * 4 + 0) * 64 + j], m1 = Mt[(c4 * 4 + 1) * 64 + j], m2 = Mt[(c4 * 4 + 2) * 64 + j], m3 = Mt[(c4 * 4 + 3) * 64 + j];
#pragma unroll
            for (int q = 0; q < 8; ++q) { const f32x4 w = *(const LAS f32x4*)(Wt + (k8 + q) * 132 + c4 * 4); acc[q] += (w[0] * m0 + w[1] * m1) + (w[2] * m2 + w[3] * m3); }
        }
        u32x4 w; w.x = pg8::cvt_pk_bf16(acc[0], acc[1]); w.y = pg8::cvt_pk_bf16(acc[2], acc[3]); w.z = pg8::cvt_pk_bf16(acc[4], acc[5]); w.w = pg8::cvt_pk_bf16(acc[6], acc[7]);
        *(u32x4*)(dst + (size_t)j * 1024 + kb * 64 + k8) = w;
        __syncthreads();
    }
}

__device__ __forceinline__ void pool_phase(const Params& p, int G) {
    const bf16_t* Q = (const bf16_t*)(p.ws + OFF_Q); bf16_t* YC = (bf16_t*)(p.ws + OFF_YCAT);
    const int total = NTOK * 64; const int tid = tid_opaque();
    for (int e = blockIdx.x * NTHREADS + tid; e < total; e += G * NTHREADS) {
        const int tok = e >> 6, col8 = (e & 63) * 8, s = tok & (SEQ - 1), r = 1 << (col8 >> 7);
        const int lo = (s - r < 0) ? 0 : s - r, hi = (s + r > SEQ - 1) ? SEQ - 1 : s + r;
        float a[8];
#pragma unroll
        for (int q = 0; q < 8; ++q) a[q] = 0.f;
        const bf16_t* base = Q + (size_t)(tok - s) * 512 + col8;
        for (int j = lo; j <= hi; ++j) { const u32x4 v = *(const u32x4*)(base + (size_t)j * 512);
            a[0] += bf_lo(v.x); a[1] += bf_hi(v.x); a[2] += bf_lo(v.y); a[3] += bf_hi(v.y); a[4] += bf_lo(v.z); a[5] += bf_hi(v.z); a[6] += bf_lo(v.w); a[7] += bf_hi(v.w); }
        const float inv = 1.0f / (float)(hi - lo + 1);
        const u32x4 c = *(const u32x4*)(base + (size_t)s * 512);
        u32x4 w; w.x = pg8::cvt_pk_bf16(a[0] * inv - bf_lo(c.x), a[1] * inv - bf_hi(c.x)); w.y = pg8::cvt_pk_bf16(a[2] * inv - bf_lo(c.y), a[3] * inv - bf_hi(c.y));
        w.z = pg8::cvt_pk_bf16(a[4] * inv - bf_lo(c.z), a[5] * inv - bf_hi(c.z)); w.w = pg8::cvt_pk_bf16(a[6] * inv - bf_lo(c.w), a[7] * inv - bf_hi(c.w));
        *(u32x4*)(YC + (size_t)tok * 1024 + 512 + col8) = w;
    }
}

constexpr int NPHASES = 2 + NL * 10;
__global__ void __launch_bounds__(NTHREADS, 2) fwd_kernel(Params p) {
    extern __shared__ __attribute__((aligned(16))) unsigned char lds_raw[];
    LAS unsigned char* lds = (LAS unsigned char*)lds_raw;
    cg::grid_group grid = cg::this_grid();
    const int G = gridDim.x;
    bf16_t* WGU = (bf16_t*)(p.ws + OFF_WGU); bf16_t* WD = (bf16_t*)(p.ws + OFF_WD); bf16_t* WA = (bf16_t*)(p.ws + OFF_WA); bf16_t* WB = (bf16_t*)(p.ws + OFF_WB);
    bf16_t* WO = (bf16_t*)(p.ws + OFF_WO); bf16_t* TM = (bf16_t*)(p.ws + OFF_TM); bf16_t* H = (bf16_t*)(p.ws + OFF_H); bf16_t* Y = (bf16_t*)(p.ws + OFF_Y);
    bf16_t* HID = (bf16_t*)(p.ws + OFF_HID); bf16_t* PT = (bf16_t*)(p.ws + OFF_PT); bf16_t* Q = (bf16_t*)(p.ws + OFF_Q); bf16_t* YC = (bf16_t*)(p.ws + OFF_YCAT);

    for (int ph = p.ph_lo; ph < p.ph_hi; ++ph) {
        if (ph > p.ph_lo) grid.sync();
        if (ph == 0) {
            transpose_phase(p, lds, G);
            tm_phase(p, G);
            mcs_phase(p, lds, G);
            norm_phase(nullptr, p.in[0], p.out, H, nullptr, p.in[1], 0.f, G);
            continue;
        }
        if (ph == 1) { fold_phase(p, lds, G); continue; }
        const int l = (ph - 2) / 10, s = (ph - 2) % 10;
        if (s == 0 || s == 7) {
            const int f = (s == 7);
            pg8::Gemm g{H, WGU + (size_t)(l * 2 + f) * 5632 * 1024, NTOK, 5632, 1024};
            pg8::Order S; S.init(NTOK, 5632, G, (int)blockIdx.x, 0);
            pg8::EpiSwiGLU E{HID};
            pg8::gemm_phase<pg8::EpiSwiGLU, pg8::Order, true, true>(lds, g, S, E);
        } else if (s == 2 || s == 6 || s == 9) {
            const float* gpost = (s == 2 ? p.in[5] : s == 6 ? p.in[12] : p.in[17]) + (size_t)l * DM;
            const float* gpre = (s == 2 ? p.in[6] + (size_t)l * DM : s == 6 ? p.in[13] + (size_t)l * DM : p.in[1] + (size_t)(l + 1) * DM);
            const bool fin = (s == 9 && l == NL - 1);
            norm_phase(Y, p.out, p.out, fin ? nullptr : H, gpost, gpre, s == 6 ? 1.0f : 0.5f, G);
        } else {
            const int nsub = (s == 3) ? 2 : 1;
            for (int sub = 0; sub < nsub; ++sub) {
                pg8::Gemm g; pg8::Order S; pg8::EpiMap E;
                if (s == 1 || s == 8) { const int f = (s == 8); g = pg8::Gemm{HID, WD + (size_t)(l * 2 + f) * 1024 * 2816, NTOK, 1024, 2816}; S.init(NTOK, 1024, G, (int)blockIdx.x, 0); E = pg8::EpiMap{Y, 1024, 0}; }
                else if (s == 3 && sub == 0) { g = pg8::Gemm{WA + (size_t)l * 1024 * 1024, H, 1024, NTOK, 1024}; S.init(1024, NTOK, G, (int)blockIdx.x, 0); E = pg8::EpiMap{PT, 4096, 1}; }
                else if (s == 3) { g = pg8::Gemm{H, WB + (size_t)l * 512 * 1024, NTOK, 512, 1024}; S.init(NTOK, 512, G, (int)blockIdx.x, 0); E = pg8::EpiMap{Q, 512, 0}; }
                else if (s == 4) { g = pg8::Gemm{TM, PT, 2048, 8192, 4096}; S.init(2048, 8192, G, (int)blockIdx.x, 1); E = pg8::EpiMap{YC, 1024, 2}; }
                else { g = pg8::Gemm{YC, WO + (size_t)l * 1024 * 1024, NTOK, 1024, 1024}; S.init(NTOK, 1024, G, (int)blockIdx.x, 0); E = pg8::EpiMap{Y, 1024, 0}; }
                pg8::gemm_phase<pg8::EpiMap, pg8::Order, true, true>(lds, g, S, E);
            }
            if (s == 4) pool_phase(p, G);
        }
    }
}

extern "C" void kernel_launch(void* const* d_in, const int* in_sizes, int n_in, void* d_out, int out_size, void* d_ws, size_t ws_size, hipStream_t stream) {
    static int grid = 0;
    if (grid == 0) {
        if (n_in != 18 || out_size != NTOK * DM || ws_size < WS_END) { fprintf(stderr, "kernel_launch: unexpected shapes (n_in %d out %d ws %zu need %zu)\n", n_in, out_size, ws_size, (size_t)WS_END); grid = -1; return; }
        int dev = 0, cus = 0, per_cu = 0;
        hipGetDevice(&dev); hipDeviceGetAttribute(&cus, hipDeviceAttributeMultiprocessorCount, dev);
        if (hipFuncSetAttribute((const void*)fwd_kernel, hipFuncAttributeMaxDynamicSharedMemorySize, LDS_BYTES) != hipSuccess) { fprintf(stderr, "kernel_launch: hipFuncSetAttribute failed\n"); grid = -1; return; }
        if (hipOccupancyMaxActiveBlocksPerMultiprocessor(&per_cu, (const void*)fwd_kernel, NTHREADS, LDS_BYTES) != hipSuccess || per_cu < 1) { fprintf(stderr, "kernel_launch: occupancy query says %d\n", per_cu); per_cu = 1; }
        (void)hipGetLastError();
        grid = cus * per_cu;
        fprintf(stderr, "kernel_launch: grid %d (cus %d x %d)\n", grid, cus, per_cu);
    }
    if (grid < 0) return;
    Params p{};
    for (int i = 0; i < 18; ++i) p.in[i] = (const float*)d_in[i];
    p.out = (float*)d_out; p.ws = (unsigned char*)d_ws;
#if MULTI_LAUNCH
    for (int ph = 0; ph < NPHASES; ++ph) { p.ph_lo = ph; p.ph_hi = ph + 1; hipLaunchKernelGGL(fwd_kernel, dim3(grid), dim3(NTHREADS), LDS_BYTES, stream, p); }
#else
    p.ph_lo = 0; p.ph_hi = NPHASES;
    void* args[] = {&p};
    hipError_t e = hipLaunchCooperativeKernel((const void*)fwd_kernel, dim3(grid), dim3(NTHREADS), args, LDS_BYTES, stream);
    if (e != hipSuccess) fprintf(stderr, "kernel_launch: cooperative launch failed: %s (grid %d)\n", hipGetErrorString(e), grid);
#endif
}
```

```cpp
#include <hip/hip_runtime.h>
#include <hip/hip_cooperative_groups.h>
#include <cstdio>
#include <cstdint>
namespace cg = cooperative_groups;

#ifndef GEMM_REPS
#define GEMM_REPS 1
#endif
#ifndef NORM_REPS
#define NORM_REPS 1
#endif
#ifndef POOL_REPS
#define POOL_REPS 1
#endif
#ifndef FOLD_REPS
#define FOLD_REPS 1
#endif
#ifndef PREP_REPS
#define PREP_REPS 1
#endif
#ifndef MULTI_LAUNCH
#define MULTI_LAUNCH 0
#endif

#define LAS __attribute__((address_space(3)))
typedef unsigned short bf16_t;
typedef short bf16x8 __attribute__((ext_vector_type(8)));
typedef float f32x4 __attribute__((ext_vector_type(4)));
typedef unsigned u32x4 __attribute__((ext_vector_type(4)));
typedef unsigned u32x2 __attribute__((ext_vector_type(2)));

__device__ __forceinline__ int tid_opaque() { int t; asm volatile("v_mov_b32 %0, %1" : "=v"(t) : "v"(threadIdx.x)); return t; }

constexpr int NTOK = 32768, DM = 1024, FF = 2816, NL = 4, SEQ = 2048, NB = 16;
constexpr float EPS = 1e-6f;
constexpr int NTHREADS = 512;
constexpr int LDS_STAGE = 131072;
constexpr int LDS_BYTES = LDS_STAGE + 16;

constexpr size_t SZ_WGU = (size_t)NL * 2 * 5632 * 1024 * 2;
constexpr size_t SZ_WD = (size_t)NL * 2 * 1024 * 2816 * 2;
constexpr size_t SZ_WA = (size_t)NL * 1024 * 1024 * 2;
constexpr size_t SZ_WB = (size_t)NL * 512 * 1024 * 2;
constexpr size_t SZ_WO = (size_t)NL * 1024 * 1024 * 2;
constexpr size_t SZ_TM = (size_t)2048 * 4096 * 2;
constexpr size_t SZ_MCS = (size_t)NL * 4 * 128 * 256 * 4;
constexpr size_t SZ_H = (size_t)NTOK * 1024 * 2;
constexpr size_t SZ_Y = (size_t)NTOK * 1024 * 2;
constexpr size_t SZ_HID = (size_t)NTOK * 2816 * 2;
constexpr size_t OFF_WGU = 0;
constexpr size_t OFF_WD = OFF_WGU + SZ_WGU;
constexpr size_t OFF_WA = OFF_WD + SZ_WD;
constexpr size_t OFF_WB = OFF_WA + SZ_WA;
constexpr size_t OFF_WO = OFF_WB + SZ_WB;
constexpr size_t OFF_TM = OFF_WO + SZ_WO;
constexpr size_t OFF_MCS = OFF_TM + SZ_TM;
constexpr size_t OFF_H = OFF_MCS + SZ_MCS;
constexpr size_t OFF_Y = OFF_H + SZ_H;
constexpr size_t OFF_HID = OFF_Y + SZ_Y;
constexpr size_t OFF_PT = OFF_HID;
constexpr size_t SZ_PT = (size_t)NB * 512 * 4096 * 2;
constexpr size_t OFF_Q = OFF_PT + SZ_PT;
constexpr size_t SZ_Q = (size_t)NTOK * 512 * 2;
constexpr size_t OFF_YCAT = OFF_Q + SZ_Q;
constexpr size_t SZ_YCAT = (size_t)NTOK * 1024 * 2;
constexpr size_t OFF_BAR = OFF_HID + SZ_HID;
constexpr size_t SZ_BAR = 16384;
constexpr size_t WS_END = OFF_BAR + SZ_BAR;
static_assert(OFF_YCAT + SZ_YCAT <= OFF_BAR, "alias region");

struct Params { const float* in[18]; float* out; unsigned char* ws; int ph_lo, ph_hi; };

namespace pg8 {
constexpr int BM = 256, BK = 64, HALF = 128, HTB = HALF * BK * 2, STAGE_BYTES = 8 * HTB, NXCD = 8, WGM = 8;
__host__ __device__ __forceinline__ int lds_byte(int r, int c) { const int st = (r >> 4) * 2 + (c >> 5), rr = r & 15, cc = c & 31, ob = rr * 64 + cc * 2; return st * 1024 + (ob ^ (((ob >> 9) & 1) << 5)); }
__host__ __device__ __forceinline__ void stage_rc(int b, int& R, int& C) { const int st = b / 1024, sb = b % 1024, swz = sb ^ (((sb >> 9) & 1) << 5); R = (st >> 1) * 16 + swz / 64; C = (st & 1) * 32 + (swz % 64) / 2; }
__host__ __device__ __forceinline__ int perm32(int rho) { const int n = rho >> 4, i = rho & 15; return 8 * (i >> 2) + 4 * n + (i & 3); }

struct Unit { int pm, pn; };
struct Gemm { const bf16_t* A; const bf16_t* Bt; int M, N, K; };

struct Order {
    int nM, nN, nwg, G, c, mode;
    __device__ void init(int M, int N, int G_, int c_, int mode_) { nM = M / BM; nN = N / BM; nwg = nM * nN; G = G_; c = c_; mode = mode_; }
    __device__ bool next(int i, Unit& u) const {
        const long L = (long)i * G + c; if (L >= nwg) return false;
        if (mode == 1) { const int xcd = (int)L & 7, j = (int)L >> 3; const int b = 2 * xcd + (j >> 4); u.pn = b * 2 + ((j >> 3) & 1); u.pm = j & 7; return true; }
        int wgid = (int)L; { const int q = nwg / NXCD, r = nwg % NXCD, xcd = wgid % NXCD, off = wgid / NXCD; wgid = (xcd < r ? xcd * (q + 1) : r * (q + 1) + (xcd - r) * q) + off; }
        const int nig = WGM * nN, gid = wgid / nig, fm = gid * WGM, gsz = (nM - fm) < WGM ? (nM - fm) : WGM;
        u.pm = fm + ((wgid % nig) % gsz); u.pn = (wgid % nig) / gsz; return true;
    }
    __device__ __forceinline__ void a_ready(const Unit&) const {}
    __device__ __forceinline__ void done(const Unit&) const {}
};

__device__ __forceinline__ unsigned cvt_pk_bf16(float lo, float hi) { unsigned r; asm volatile("v_cvt_pk_bf16_f32 %0, %1, %2" : "=v"(r) : "v"(lo), "v"(hi)); return r; }

struct EpiMap {
    static constexpr bool PERM = true, AFTER_DRAIN = false;
    bf16_t* O; int ldc; int mode; int dry;
    __device__ __forceinline__ void operator()(const f32x4 (&acc)[2][2][4][2], const Unit& u, int wr, int wc, int fr, int fq) const {
        if (dry) return;
        size_t tb; int ld = ldc;
        if (mode == 0) tb = (size_t)u.pm * 256 * (size_t)ldc + (size_t)u.pn * 256;
        else if (mode == 1) { tb = ((size_t)((u.pn >> 3) * 512 + (u.pm & 1) * 256)) * 4096 + (size_t)((u.pm >> 1) * 2048 + (u.pn & 7) * 256); ld = 4096; }
        else { tb = ((size_t)((u.pn >> 1) * 2048 + u.pm * 256)) * 1024 + (size_t)((u.pn & 1) * 256); ld = 1024; }
        bf16_t* base = O + tb + (size_t)(wr * 64 + fr) * ld + wc * 32 + 8 * fq;
#pragma unroll
        for (int ai = 0; ai < 2; ++ai)
#pragma unroll
            for (int m = 0; m < 4; ++m) { bf16_t* rowp = base + (size_t)(ai * HALF + m * 16) * ld;
#pragma unroll
                for (int bj = 0; bj < 2; ++bj) { const f32x4 v0 = acc[ai][bj][m][0], v1 = acc[ai][bj][m][1];
                    u32x4 w; w.x = cvt_pk_bf16(v0[0], v0[1]); w.y = cvt_pk_bf16(v0[2], v0[3]); w.z = cvt_pk_bf16(v1[0], v1[1]); w.w = cvt_pk_bf16(v1[2], v1[3]);
                    *(u32x4*)(rowp + bj * HALF) = w; } }
    }
};
__device__ __forceinline__ float silu_mul(float a, float b) { return a * __builtin_amdgcn_rcpf(1.0f + __expf(-a)) * b; }
struct EpiSwiGLU {
    static constexpr bool PERM = true, AFTER_DRAIN = false;
    bf16_t* O; int dry;
    __device__ __forceinline__ void operator()(const f32x4 (&acc)[2][2][4][2], const Unit& u, int wr, int wc, int fr, int fq) const {
        if (dry) return;
        bf16_t* base = O + (size_t)(u.pm * 256 + wr * 64 + fr) * FF + u.pn * 128 + wc * 32 + 8 * fq;
#pragma unroll
        for (int ai = 0; ai < 2; ++ai)
#pragma unroll
            for (int m = 0; m < 4; ++m) { bf16_t* rowp = base + (size_t)(ai * HALF + m * 16) * FF;
                const f32x4 g0 = acc[ai][0][m][0], g1 = acc[ai][0][m][1], u0 = acc[ai][1][m][0], u1 = acc[ai][1][m][1];
                u32x4 w; w.x = cvt_pk_bf16(silu_mul(g0[0], u0[0]), silu_mul(g0[1], u0[1])); w.y = cvt_pk_bf16(silu_mul(g0[2], u0[2]), silu_mul(g0[3], u0[3]));
                w.z = cvt_pk_bf16(silu_mul(g1[0], u1[0]), silu_mul(g1[1], u1[1])); w.w = cvt_pk_bf16(silu_mul(g1[2], u1[2]), silu_mul(g1[3], u1[3]));
                *(u32x4*)rowp = w; }
    }
};

template <class Epi, class Sched, bool ALIGN_EPI = false, bool SP2 = false>
__device__ __forceinline__ void gemm_phase(LAS unsigned char* lds, const Gemm g, const Sched& S, const Epi& E) {
    const int tid = tid_opaque(), wid = __builtin_amdgcn_readfirstlane(tid >> 6), lane = tid & 63, wr = wid >> 2, wc = wid & 3, fr = lane & 15, fq = lane >> 4;
    const int K = g.K, nt = K / BK;
    unsigned voffA[2], voffB[2];
#pragma unroll
    for (int i = 0; i < 2; ++i) { int R, C; stage_rc(tid * 16 + i * 8192, R, C); const int Rb = Epi::PERM ? ((R & ~31) + perm32(R & 31)) : R;
        voffA[i] = (unsigned)(R * K + C) * 2u; voffB[i] = (unsigned)(Rb * K + C) * 2u; }
    const size_t kstep = (size_t)(BK * 2);
    const size_t hstep = (size_t)HALF * K * 2;
    const size_t tstep = 2 * hstep;
    const unsigned ldsw = (unsigned)wid * 1024u;
    const int aoff = lds_byte(wr * 64 + fr, fq * 8), boff = lds_byte(wc * 32 + fr, fq * 8);
#define PG8_SA(b, h) (((b) * 2 + (h)) * HTB)
#define PG8_SB(b, h) ((4 + (b) * 2 + (h)) * HTB)
#define PG8_STAGE(bufoff, gbase, voff) do { _Pragma("unroll") for (int _i = 0; _i < 2; ++_i) \
        __builtin_amdgcn_global_load_lds((const unsigned*)((const char*)(gbase) + (voff)[_i]), (LAS unsigned*)(lds + (bufoff) + ldsw + _i * 8192), 16, 0, 0); } while (0)
#define PG8_LDA(dst, b, h) do { _Pragma("unroll") for (int m = 0; m < 4; ++m) _Pragma("unroll") for (int k = 0; k < 2; ++k) dst[m][k] = *(const LAS bf16x8*)(lds + PG8_SA(b, h) + aoff + m * 2048 + k * 1024); } while (0)
#define PG8_LDB(dst, b, h) do { _Pragma("unroll") for (int n = 0; n < 2; ++n) _Pragma("unroll") for (int k = 0; k < 2; ++k) dst[n][k] = *(const LAS bf16x8*)(lds + PG8_SB(b, h) + boff + n * 2048 + k * 1024); } while (0)
#define PG8_MMA(ai, bj, At, Bt) do { __builtin_amdgcn_s_setprio(1); _Pragma("unroll") for (int m = 0; m < 4; ++m) _Pragma("unroll") for (int n = 0; n < 2; ++n) _Pragma("unroll") for (int k = 0; k < 2; ++k) \
        acc[ai][bj][m][n] = __builtin_amdgcn_mfma_f32_16x16x32_bf16(Bt[n][k], At[m][k], acc[ai][bj][m][n], 0, 0, 0); __builtin_amdgcn_s_setprio(0); } while (0)
#define PG8_WAIT_V(n) asm volatile("s_waitcnt vmcnt(" #n ")" ::: "memory")
#define PG8_WAIT_L(n) asm volatile("s_waitcnt lgkmcnt(" #n ")" ::: "memory")
#define PG8_BAR __builtin_amdgcn_s_barrier()
#define PG8_SCHED __builtin_amdgcn_sched_barrier(0)
    Unit cur, nxt; int ui = 0;
    if (!S.next(0, cur)) return;
    f32x4 acc[2][2][4][2];
#pragma unroll
    for (int a = 0; a < 2; ++a)
#pragma unroll
        for (int b = 0; b < 2; ++b)
#pragma unroll
            for (int m = 0; m < 4; ++m)
#pragma unroll
                for (int n = 0; n < 2; ++n) acc[a][b][m][n] = (f32x4){0.f, 0.f, 0.f, 0.f};
    bf16x8 At[4][2], B0[2][2], B1[2][2];
    const char* cA = (const char*)g.A + (size_t)cur.pm * tstep; const char* cB = (const char*)g.Bt + (size_t)cur.pn * tstep;
    S.a_ready(cur);
    if constexpr (SP2) {
        PG8_STAGE(PG8_SB(0, 0), cB, voffB); PG8_STAGE(PG8_SB(0, 1), cB + hstep, voffB); PG8_STAGE(PG8_SA(0, 0), cA, voffA); PG8_STAGE(PG8_SA(0, 1), cA + hstep, voffA);
        if (wr == 1) PG8_BAR;
        PG8_WAIT_V(2); PG8_BAR;
        PG8_STAGE(PG8_SB(1, 0), cB + kstep, voffB); PG8_STAGE(PG8_SA(1, 0), cA + kstep, voffA); PG8_STAGE(PG8_SB(1, 1), cB + hstep + kstep, voffB);
        PG8_WAIT_V(6); PG8_BAR;
    } else {
        PG8_STAGE(PG8_SB(0, 0), cB, voffB); PG8_STAGE(PG8_SA(0, 0), cA, voffA); PG8_STAGE(PG8_SB(0, 1), cB + hstep, voffB); PG8_STAGE(PG8_SA(0, 1), cA + hstep, voffA);
        if (wr == 1) PG8_BAR;
        PG8_WAIT_V(4); PG8_BAR;
        PG8_STAGE(PG8_SB(1, 0), cB + kstep, voffB); PG8_STAGE(PG8_SA(1, 0), cA + kstep, voffA); PG8_STAGE(PG8_SB(1, 1), cB + hstep + kstep, voffB);
        PG8_WAIT_V(6); PG8_BAR;
    }
    for (;;) {
        const bool has_next = S.next(ui + 1, nxt);
        const char* nA = has_next ? (const char*)g.A + (size_t)nxt.pm * tstep : cA; const char* nB = has_next ? (const char*)g.Bt + (size_t)nxt.pn * tstep : cB;
        for (int t = 0; t < nt; t += 2) {
            const bool last = (t == nt - 2);
            const char* a1 = cA + (size_t)(t + 1) * kstep;
            const char* a2 = last ? nA : cA + (size_t)(t + 2) * kstep; const char* b2 = last ? nB : cB + (size_t)(t + 2) * kstep;
            const char* a3 = a2 + kstep; const char* b3 = b2 + kstep;
            if (last && has_next) S.a_ready(nxt);
            if constexpr (SP2) {
            PG8_LDB(B0, 0, 0); PG8_LDB(B1, 0, 1); PG8_SCHED; PG8_LDA(At, 0, 0); PG8_STAGE(PG8_SA(1, 1), a1 + hstep, voffA);
            PG8_WAIT_V(8); PG8_WAIT_L(0); PG8_BAR; PG8_MMA(0, 0, At, B0); PG8_MMA(0, 1, At, B1); PG8_BAR; PG8_SCHED;
            PG8_LDA(At, 0, 1); PG8_STAGE(PG8_SB(0, 0), b2, voffB); PG8_STAGE(PG8_SB(0, 1), b2 + hstep, voffB); PG8_STAGE(PG8_SA(0, 0), a2, voffA);
            PG8_WAIT_V(8); PG8_WAIT_L(0); PG8_BAR; PG8_MMA(1, 0, At, B0); PG8_MMA(1, 1, At, B1); PG8_BAR; PG8_SCHED;
            PG8_LDB(B0, 1, 0); PG8_LDB(B1, 1, 1); PG8_SCHED; PG8_LDA(At, 1, 0); PG8_STAGE(PG8_SA(0, 1), a2 + hstep, voffA);
            PG8_WAIT_V(8); PG8_WAIT_L(0); PG8_BAR; PG8_MMA(0, 0, At, B0); PG8_MMA(0, 1, At, B1); PG8_BAR; PG8_SCHED;
            PG8_LDA(At, 1, 1); PG8_STAGE(PG8_SB(1, 0), b3, voffB); PG8_STAGE(PG8_SB(1, 1), b3 + hstep, voffB); PG8_STAGE(PG8_SA(1, 0), a3, voffA);
            PG8_WAIT_V(8); PG8_WAIT_L(0); PG8_BAR; PG8_MMA(1, 0, At, B0); PG8_MMA(1, 1, At, B1); PG8_BAR; PG8_SCHED;
            } else {
            PG8_LDB(B0, 0, 0); PG8_SCHED; PG8_LDA(At, 0, 0); PG8_STAGE(PG8_SA(1, 1), a1 + hstep, voffA);
            PG8_WAIT_L(8); PG8_BAR; PG8_WAIT_L(0); PG8_MMA(0, 0, At, B0); PG8_BAR; PG8_SCHED;
            PG8_LDB(B1, 0, 1); PG8_STAGE(PG8_SB(0, 0), b2, voffB);
            PG8_BAR; PG8_WAIT_L(0); PG8_MMA(0, 1, At, B1); PG8_BAR;
            PG8_LDA(At, 0, 1); PG8_STAGE(PG8_SA(0, 0), a2, voffA);
            PG8_BAR; PG8_WAIT_L(0); PG8_MMA(1, 0, At, B0); PG8_BAR; PG8_SCHED;
            PG8_STAGE(PG8_SB(0, 1), b2 + hstep, voffB);
            PG8_WAIT_V(6); PG8_BAR; PG8_MMA(1, 1, At, B1); PG8_BAR;
            PG8_LDB(B0, 1, 0); PG8_SCHED; PG8_LDA(At, 1, 0); PG8_STAGE(PG8_SA(0, 1), a2 + hstep, voffA);
            PG8_WAIT_L(8); PG8_BAR; PG8_WAIT_L(0); PG8_MMA(0, 0, At, B0); PG8_BAR; PG8_SCHED;
            PG8_LDB(B1, 1, 1); PG8_STAGE(PG8_SB(1, 0), b3, voffB);
            PG8_BAR; PG8_WAIT_L(0); PG8_MMA(0, 1, At, B1); PG8_BAR;
            PG8_LDA(At, 1, 1); PG8_STAGE(PG8_SA(1, 0), a3, voffA);
            PG8_BAR; PG8_WAIT_L(0); PG8_MMA(1, 0, At, B0); PG8_BAR; PG8_SCHED;
            PG8_STAGE(PG8_SB(1, 1), b3 + hstep, voffB);
            PG8_WAIT_V(6); PG8_BAR; PG8_MMA(1, 1, At, B1); PG8_BAR;
            }
        }
        if constexpr (ALIGN_EPI) { if (wr == 0) PG8_BAR; }
        if constexpr (!Epi::AFTER_DRAIN) { E(acc, cur, wr, wc, fr, fq); S.done(cur); }
        if (!has_next) break;
#pragma unroll
        for (int a = 0; a < 2; ++a)
#pragma unroll
            for (int b = 0; b < 2; ++b)
#pragma unroll
                for (int m = 0; m < 4; ++m)
#pragma unroll
                    for (int n = 0; n < 2; ++n) acc[a][b][m][n] = (f32x4){0.f, 0.f, 0.f, 0.f};
        cur = nxt; cA = nA; cB = nB; ++ui;
        if constexpr (ALIGN_EPI) { if (wr == 1) PG8_BAR; }
    }
    PG8_WAIT_V(0);
    if constexpr (!ALIGN_EPI) { if (wr == 0) PG8_BAR; }
    PG8_BAR;
#undef PG8_SA
#undef PG8_SB
#undef PG8_STAGE
#undef PG8_LDA
#undef PG8_LDB
#undef PG8_MMA
#undef PG8_WAIT_V
#undef PG8_WAIT_L
#undef PG8_BAR
#undef PG8_SCHED
}
}

__device__ __forceinline__ float wave_sum(float v) {
    v += __shfl_xor(v, 32); v += __shfl_xor(v, 16); v += __shfl_xor(v, 8); v += __shfl_xor(v, 4); v += __shfl_xor(v, 2); v += __shfl_xor(v, 1); return v;
}
__device__ __forceinline__ float bf_lo(unsigned u) { return __uint_as_float(u << 16); }
__device__ __forceinline__ float bf_hi(unsigned u) { return __uint_as_float(u & 0xffff0000u); }

struct NormRows { f32x4 x0[4], x1[4]; u32x2 y0[4], y1[4]; };
__device__ __forceinline__ void norm_load(NormRows& r, const bf16_t* y, const float* xin, int row, int nw, int lane, bool has_y) {
    const int r1 = row + nw; const size_t o0 = (size_t)row * DM + lane * 4, o1 = (size_t)(r1 < NTOK ? r1 : row) * DM + lane * 4;
#pragma unroll
    for (int j = 0; j < 4; ++j) { r.x0[j] = __builtin_nontemporal_load((const f32x4*)(xin + o0 + 256 * j)); r.x1[j] = __builtin_nontemporal_load((const f32x4*)(xin + o1 + 256 * j)); }
    if (has_y) {
#pragma unroll
        for (int j = 0; j < 4; ++j) { r.y0[j] = __builtin_nontemporal_load((const u32x2*)(y + o0 + 256 * j)); r.y1[j] = __builtin_nontemporal_load((const u32x2*)(y + o1 + 256 * j)); }
    }
}
__device__ __forceinline__ void norm_phase(const bf16_t* y, const float* xin, float* xout, bf16_t* h, const float* gpost, const float* gpre, float coef, int G) {
    const int tid = tid_opaque(); const int lane = tid & 63, wid = tid >> 6;
    const int gw = blockIdx.x * 8 + wid, nw = G * 8;
    const bool has_y = (y != nullptr), has_h = (h != nullptr);
    f32x4 gp[4], gq[4];
#pragma unroll
    for (int j = 0; j < 4; ++j) {
        gp[j] = has_y ? *(const f32x4*)(gpost + lane * 4 + 256 * j) : (f32x4){0.f, 0.f, 0.f, 0.f};
        gq[j] = has_h ? *(const f32x4*)(gpre + lane * 4 + 256 * j) : (f32x4){0.f, 0.f, 0.f, 0.f};
    }
    NormRows cur, nxt;
    if (gw < NTOK) norm_load(cur, y, xin, gw, nw, lane, has_y);
    for (int row = gw; row < NTOK; row += 2 * nw) {
        if (row + 2 * nw < NTOK) norm_load(nxt, y, xin, row + 2 * nw, nw, lane, has_y);
        const int r1 = row + nw; const bool ok1 = r1 < NTOK;
        const size_t o0 = (size_t)row * DM + lane * 4, o1 = (size_t)(ok1 ? r1 : row) * DM + lane * 4;
        f32x4 x0[4], x1[4];
#pragma unroll
        for (int j = 0; j < 4; ++j) { x0[j] = cur.x0[j]; x1[j] = cur.x1[j]; }
        if (has_y) {
            f32x4 v0[4], v1[4]; float s0 = 0.f, s1 = 0.f;
#pragma unroll
            for (int j = 0; j < 4; ++j) {
                v0[j] = (f32x4){bf_lo(cur.y0[j].x), bf_hi(cur.y0[j].x), bf_lo(cur.y0[j].y), bf_hi(cur.y0[j].y)};
                v1[j] = (f32x4){bf_lo(cur.y1[j].x), bf_hi(cur.y1[j].x), bf_lo(cur.y1[j].y), bf_hi(cur.y1[j].y)};
                s0 += (v0[j][0] * v0[j][0] + v0[j][1] * v0[j][1]) + (v0[j][2] * v0[j][2] + v0[j][3] * v0[j][3]);
                s1 += (v1[j][0] * v1[j][0] + v1[j][1] * v1[j][1]) + (v1[j][2] * v1[j][2] + v1[j][3] * v1[j][3]);
            }
            s0 = wave_sum(s0); s1 = wave_sum(s1);
            const float c0 = coef * rsqrtf(s0 * (1.0f / DM) + EPS), c1 = coef * rsqrtf(s1 * (1.0f / DM) + EPS);
#pragma unroll
            for (int j = 0; j < 4; ++j) { x0[j] += v0[j] * gp[j] * c0; x1[j] += v1[j] * gp[j] * c1; }
        }
#pragma unroll
        for (int j = 0; j < 4; ++j) { *(f32x4*)(xout + o0 + 256 * j) = x0[j]; if (ok1) *(f32x4*)(xout + o1 + 256 * j) = x1[j]; }
        if (has_h) {
            float s0 = 0.f, s1 = 0.f;
#pragma unroll
            for (int j = 0; j < 4; ++j) {
                s0 += (x0[j][0] * x0[j][0] + x0[j][1] * x0[j][1]) + (x0[j][2] * x0[j][2] + x0[j][3] * x0[j][3]);
                s1 += (x1[j][0] * x1[j][0] + x1[j][1] * x1[j][1]) + (x1[j][2] * x1[j][2] + x1[j][3] * x1[j][3]);
            }
            s0 = wave_sum(s0); s1 = wave_sum(s1);
            const float c0 = rsqrtf(s0 * (1.0f / DM) + EPS), c1 = rsqrtf(s1 * (1.0f / DM) + EPS);
#pragma unroll
            for (int j = 0; j < 4; ++j) {
                const f32x4 a = x0[j] * gq[j] * c0, b = x1[j] * gq[j] * c1;
                u32x2 wa, wb; wa.x = pg8::cvt_pk_bf16(a[0], a[1]); wa.y = pg8::cvt_pk_bf16(a[2], a[3]); wb.x = pg8::cvt_pk_bf16(b[0], b[1]); wb.y = pg8::cvt_pk_bf16(b[2], b[3]);
                *(u32x2*)(h + o0 + 256 * j) = wa; if (ok1) *(u32x2*)(h + o1 + 256 * j) = wb;
            }
        }
        cur = nxt;
    }
}

__device__ __forceinline__ void transpose_phase(const Params& p, LAS unsigned char* lds, int G) {
    LAS float* T = (LAS float*)lds;
    const int tid = tid_opaque();
    constexpr int TPL = 4480;
    const int nrounds = NL * TPL / 4;
    bf16_t* WGU = (bf16_t*)(p.ws + OFF_WGU); bf16_t* WD = (bf16_t*)(p.ws + OFF_WD); bf16_t* WO = (bf16_t*)(p.ws + OFF_WO);
    for (int R = blockIdx.x; R < nrounds; R += G) {
        const int ti0 = R * 4, l = ti0 / TPL, r = ti0 % TPL; int m = r / 704; if (m > 6) m = 6; const int t0 = r - m * 704;
        const float* src; int N, tn; bf16_t* dst; int ldd, kind;
        if (m == 0) { src = p.in[2] + (size_t)l * 1024 * 2816; N = 2816; tn = 44; dst = WGU + (size_t)(l * 2 + 0) * 5632 * 1024; ldd = 1024; kind = 0; }
        else if (m == 1) { src = p.in[3] + (size_t)l * 1024 * 2816; N = 2816; tn = 44; dst = WGU + (size_t)(l * 2 + 0) * 5632 * 1024; ldd = 1024; kind = 1; }
        else if (m == 2) { src = p.in[4] + (size_t)l * 2816 * 1024; N = 1024; tn = 16; dst = WD + (size_t)(l * 2 + 0) * 1024 * 2816; ldd = 2816; kind = 2; }
        else if (m == 3) { src = p.in[14] + (size_t)l * 1024 * 2816; N = 2816; tn = 44; dst = WGU + (size_t)(l * 2 + 1) * 5632 * 1024; ldd = 1024; kind = 0; }
        else if (m == 4) { src = p.in[15] + (size_t)l * 1024 * 2816; N = 2816; tn = 44; dst = WGU + (size_t)(l * 2 + 1) * 5632 * 1024; ldd = 1024; kind = 1; }
        else if (m == 5) { src = p.in[16] + (size_t)l * 2816 * 1024; N = 1024; tn = 16; dst = WD + (size_t)(l * 2 + 1) * 1024 * 2816; ldd = 2816; kind = 2; }
        else { src = p.in[11] + (size_t)l * 1024 * 1024; N = 1024; tn = 16; dst = WO + (size_t)l * 1024 * 1024; ldd = 1024; kind = 2; }
        f32x4 v[4][2];
#pragma unroll
        for (int q = 0; q < 4; ++q) { const int t = t0 + q, kt = t / tn, ntile = t - kt * tn;
#pragma unroll
            for (int i = 0; i < 2; ++i) v[q][i] = *(const f32x4*)(src + (size_t)(kt * 64 + (tid >> 4) + 32 * i) * N + ntile * 64 + (tid & 15) * 4); }
#pragma unroll
        for (int q = 0; q < 4; ++q)
#pragma unroll
            for (int i = 0; i < 2; ++i) { LAS float* d = T + q * 4160 + ((tid >> 4) + 32 * i) * 65 + (tid & 15) * 4; d[0] = v[q][i][0]; d[1] = v[q][i][1]; d[2] = v[q][i][2]; d[3] = v[q][i][3]; }
        __syncthreads();
#pragma unroll
        for (int q = 0; q < 4; ++q) { const int t = t0 + q, kt = t / tn, ntile = t - kt * tn;
            const int nl = tid >> 3, k8 = (tid & 7) * 8; const int n = ntile * 64 + nl;
            const int drow = (kind == 2) ? n : ((n >> 7) * 256 + (n & 127) + (kind == 1 ? 128 : 0));
            const LAS float* s = T + q * 4160 + k8 * 65 + nl;
            u32x4 w; w.x = pg8::cvt_pk_bf16(s[0], s[65]); w.y = pg8::cvt_pk_bf16(s[130], s[195]); w.z = pg8::cvt_pk_bf16(s[260], s[325]); w.w = pg8::cvt_pk_bf16(s[390], s[455]);
            *(u32x4*)(dst + (size_t)drow * ldd + kt * 64 + k8) = w; }
        __syncthreads();
    }
}

__device__ __forceinline__ void tm_phase(const Params& p, int G) {
    bf16_t* TM = (bf16_t*)(p.ws + OFF_TM);
    const int total = 2048 * 4096 / 8; const int tid = tid_opaque();
    for (int e = blockIdx.x * NTHREADS + tid; e < total; e += G * NTHREADS) {
        const int s = e >> 9, k0 = (e & 511) * 8; float v[8];
#pragma unroll
        for (int j = 0; j < 8; ++j) { const int k = k0 + j, kk = k & 2047; const int ph = (s * kk) & 2047; const float a = (float)ph * (1.0f / 1024.0f);
            v[j] = (k < 2048) ? cospif(a) * (1.0f / 512.0f) : -sinpif(a) * (1.0f / 512.0f); }
        u32x4 w; w.x = pg8::cvt_pk_bf16(v[0], v[1]); w.y = pg8::cvt_pk_bf16(v[2], v[3]); w.z = pg8::cvt_pk_bf16(v[4], v[5]); w.w = pg8::cvt_pk_bf16(v[6], v[7]);
        *(u32x4*)(TM + (size_t)e * 8) = w;
    }
}

__device__ __forceinline__ void mcs_phase(const Params& p, LAS unsigned char* lds, int G) {
    LAS float* tab = (LAS float*)lds;
    const int tid = tid_opaque();
    if (tid < 128) { const float a = (float)tid * (1.0f / 64.0f); tab[tid] = cospif(a); tab[128 + tid] = sinpif(a); }
    __syncthreads();
    float* MCS = (float*)(p.ws + OFF_MCS); const float* fw = p.in[8];
    const int total = NL * 4 * 128 * 256;
    for (int e = blockIdx.x * NTHREADS + tid; e < total; e += G * NTHREADS) {
        const int col = e & 255, c = (e >> 8) & 127, lh = e >> 15; const int part = col >> 7, d = col & 127;
        const float* w = fw + (size_t)lh * 128 * 128 + d; float acc = 0.f;
        for (int k = 0; k < 128; ++k) acc += tab[part * 128 + ((c * k) & 127)] * w[(size_t)k * 128];
        MCS[e] = acc;
    }
    __syncthreads();
}

__device__ __forceinline__ void fold_phase(const Params& p, LAS unsigned char* lds, int G) {
    LAS float* Wt = (LAS float*)lds;
    LAS float* Mt = (LAS float*)(lds + 64 * 132 * 4);
    const int tid = tid_opaque();
    const float* MCS = (const float*)(p.ws + OFF_MCS);
    bf16_t* WA = (bf16_t*)(p.ws + OFF_WA); bf16_t* WB = (bf16_t*)(p.ws + OFF_WB);
    const int nitems = NL * 24 * 16;
    for (int it = blockIdx.x; it < nitems; it += G) {
        const int kb = it & 15, ch = (it >> 4) % 24, l = (it >> 4) / 24;
        const float* win = p.in[7] + (size_t)l * 1024 * 1024;
        const float* msrc; int ldm, wcol; bf16_t* dst; const float* scl = nullptr;
        if (ch < 16) { const int h = ch >> 2, cc = ch & 3; msrc = MCS + (size_t)(l * 4 + h) * 128 * 256 + cc * 64; ldm = 256; wcol = h * 128;
            dst = WA + ((size_t)l * 1024 + (cc >> 1) * 512 + h * 128 + (cc & 1) * 64) * 1024; }
        else { const int g = (ch - 16) >> 1, d0 = ((ch - 16) & 1) * 64; msrc = p.in[9] + (size_t)(l * 4 + g) * 128 * 128 + d0; ldm = 128; wcol = 512 + g * 128;
            dst = WB + ((size_t)l * 512 + g * 128 + d0) * 1024; scl = p.in[10] + (size_t)l * 512 + g * 128 + d0; }
#pragma unroll
        for (int i = 0; i < 4; ++i) { const int kk = (tid >> 5) + 16 * i, c4 = (tid & 31) * 4;
            *(LAS f32x4*)(Wt + kk * 132 + c4) = *(const f32x4*)(win + (size_t)(kb * 64 + kk) * 1024 + wcol + c4); }
#pragma unroll
        for (int i = 0; i < 4; ++i) { const int c = (tid >> 4) + 32 * i, j4 = (tid & 15) * 4;
            f32x4 mv = *(const f32x4*)(msrc + (size_t)c * ldm + j4);
            if (scl) mv *= *(const f32x4*)(scl + j4);
            *(LAS f32x4*)(Mt + c * 64 + j4) = mv; }
        __syncthreads();
        const int j = tid & 63, k8 = (tid >> 6) * 8;
        float acc[8];
#pragma unroll
        for (int q = 0; q < 8; ++q) acc[q] = 0.f;
        for (int c4 = 0; c4 < 32; ++c4) {
            const float m0 = Mt[(c4 * 4 + 0) * 64 + j], m1 = Mt[(c4 * 4 + 1) * 64 + j], m2 = Mt[(c4 * 4 + 2) * 64 + j], m3 = Mt[(c4 * 4 + 3) * 64 + j];
#pragma unroll
            for (int q = 0; q < 8; ++q) { const f32x4 w = *(const LAS f32x4*)(Wt + (k8 + q) * 132 + c4 * 4); acc[q] += (w[0] * m0 + w[1] * m1) + (w[2] * m2 + w[3] * m3); }
        }
        u32x4 w; w.x = pg8::cvt_pk_bf16(acc[0], acc[1]); w.y = pg8::cvt_pk_bf16(acc[2], acc[3]); w.z = pg8::cvt_pk_bf16(acc[4], acc[5]); w.w = pg8::cvt_pk_bf16(acc[6], acc[7]);
        *(u32x4*)(dst + (size_t)j * 1024 + kb * 64 + k8) = w;
        __syncthreads();
    }
}

__device__ __forceinline__ void pool_phase(const Params& p, int G) {
    const bf16_t* Q = (const bf16_t*)(p.ws + OFF_Q); bf16_t* YC = (bf16_t*)(p.ws + OFF_YCAT);
    const int total = NTOK * 64; const int tid = tid_opaque();
    for (int e = blockIdx.x * NTHREADS + tid; e < total; e += G * NTHREADS) {
        const int tok = e >> 6, col8 = (e & 63) * 8, s = tok & (SEQ - 1), r = 1 << (col8 >> 7);
        const int lo = (s - r < 0) ? 0 : s - r, hi = (s + r > SEQ - 1) ? SEQ - 1 : s + r;
        float a[8];
#pragma unroll
        for (int q = 0; q < 8; ++q) a[q] = 0.f;
        const bf16_t* base = Q + (size_t)(tok - s) * 512 + col8;
        for (int j = lo; j <= hi; ++j) { const u32x4 v = *(const u32x4*)(base + (size_t)j * 512);
            a[0] += bf_lo(v.x); a[1] += bf_hi(v.x); a[2] += bf_lo(v.y); a[3] += bf_hi(v.y); a[4] += bf_lo(v.z); a[5] += bf_hi(v.z); a[6] += bf_lo(v.w); a[7] += bf_hi(v.w); }
        const float inv = 1.0f / (float)(hi - lo + 1);
        const u32x4 c = *(const u32x4*)(base + (size_t)s * 512);
        u32x4 w; w.x = pg8::cvt_pk_bf16(a[0] * inv - bf_lo(c.x), a[1] * inv - bf_hi(c.x)); w.y = pg8::cvt_pk_bf16(a[2] * inv - bf_lo(c.y), a[3] * inv - bf_hi(c.y));
        w.z = pg8::cvt_pk_bf16(a[4] * inv - bf_lo(c.z), a[5] * inv - bf_hi(c.z)); w.w = pg8::cvt_pk_bf16(a[6] * inv - bf_lo(c.w), a[7] * inv - bf_hi(c.w));
        *(u32x4*)(YC + (size_t)tok * 1024 + 512 + col8) = w;
    }
}

#define XB_TMO      128
#define XB_XCNT(j)  (256  + 64 * (j))
#define XB_XSUB(j)  (1280 + 64 * (j))
#define XB_XGEN(j)  (2304 + 64 * (j))
#define XB_TOP      3328
#define XB_TOPGEN   3392
#define XCD_BAR_WORDS 3456
#define XB_SPIN_CAP (1u << 22)
__device__ __forceinline__ unsigned xb_ld(unsigned* p)              { return __hip_atomic_load(p, __ATOMIC_RELAXED, __HIP_MEMORY_SCOPE_AGENT); }
__device__ __forceinline__ unsigned xb_add(unsigned* p, unsigned v) { return __hip_atomic_fetch_add(p, v, __ATOMIC_RELAXED, __HIP_MEMORY_SCOPE_AGENT); }
__device__ __forceinline__ unsigned xb_xcc_id() { return (unsigned)__builtin_amdgcn_s_getreg((3 << 11) | 20) & 0xFu; }
#define XB_SPIN(cond, bar) do { unsigned _sp = 0; while (cond) { __builtin_amdgcn_s_sleep(1); \
    if ((++_sp & 255u) == 0u) { if (xb_ld(&(bar)[XB_TMO])) break; if (_sp > XB_SPIN_CAP) { atomicAdd(&(bar)[XB_TMO], 1u); break; } } } } while (0)
struct XcdBarrier { unsigned* bar; unsigned x; volatile LAS unsigned* st; };
__device__ __forceinline__ XcdBarrier xcd_barrier_post(unsigned* bar, volatile LAS unsigned* st) {
    XcdBarrier b; b.bar = bar; b.x = xb_xcc_id(); b.st = st;
    if (threadIdx.x == 0) (void)xb_add(&bar[XB_XCNT(b.x)], 1u);
    return b;
}
__device__ __forceinline__ void xcd_barrier_complete(unsigned* bar, unsigned x, unsigned& nloc, unsigned& nx) {
    const unsigned G = gridDim.x * gridDim.y * gridDim.z;
    unsigned sum, cnt, mine, sp = 0u;
    for (;;) {
        sum = 0u; cnt = 0u; mine = 0u;
#pragma unroll
        for (unsigned j = 0; j < 16; ++j) { const unsigned c = xb_ld(&bar[XB_XCNT(j)]); sum += c; cnt += (c > 0u) ? 1u : 0u; mine = (j == x) ? c : mine; }
        if (sum == G) break;
        __builtin_amdgcn_s_sleep(1);
        if ((++sp & 255u) == 0u) { if (xb_ld(&bar[XB_TMO])) break; if (sp > XB_SPIN_CAP) { atomicAdd(&bar[XB_TMO], 1u); break; } }
    }
    nloc = mine > 0u ? mine : 1u; nx = cnt > 0u ? cnt : 1u;
}
__device__ __forceinline__ void xcd_barrier(const XcdBarrier& b) {
    asm volatile("s_waitcnt vmcnt(0)" ::: "memory");
    __syncthreads();
    if (threadIdx.x == 0) {
        unsigned* bar = b.bar;
        __builtin_amdgcn_s_waitcnt(0);
        unsigned nloc = b.st[0], nx = b.st[1];
        if (nloc == 0u) { xcd_barrier_complete(bar, b.x, nloc, nx); b.st[0] = nloc; b.st[1] = nx; }
        const unsigned old = xb_add(&bar[XB_XSUB(b.x)], 1u);
        const unsigned gen = old / nloc;
        if (old + 1u == (gen + 1u) * nloc) {
            __builtin_amdgcn_fence(__ATOMIC_RELEASE, "agent");
            asm volatile("s_waitcnt vmcnt(0)" ::: "memory");
            const unsigned og = xb_add(&bar[XB_TOP], 1u);
            const unsigned tg = og / nx;
            if (og + 1u == (tg + 1u) * nx) xb_add(&bar[XB_TOPGEN], 1u);
            else XB_SPIN(xb_ld(&bar[XB_TOPGEN]) == tg, bar);
            __builtin_amdgcn_fence(__ATOMIC_ACQUIRE, "agent");
            xb_add(&bar[XB_XGEN(b.x)], 1u);
            asm volatile("s_waitcnt vmcnt(0)" ::: "memory");
        } else {
            XB_SPIN(xb_ld(&bar[XB_XGEN(b.x)]) == gen, bar);
            __builtin_amdgcn_fence(__ATOMIC_ACQUIRE, "agent");
            asm volatile("s_waitcnt vmcnt(0)" ::: "memory");
        }
    }
    __syncthreads();
}

constexpr int NPHASES = 2 + NL * 10;
__global__ void __launch_bounds__(NTHREADS, 2) fwd_kernel(Params p) {
    extern __shared__ __attribute__((aligned(16))) unsigned char lds_raw[];
    LAS unsigned char* lds = (LAS unsigned char*)lds_raw;
    cg::grid_group grid = cg::this_grid();
    const int G = gridDim.x;
    volatile LAS unsigned* bst = (volatile LAS unsigned*)(lds + LDS_STAGE);
    if (threadIdx.x == 0) { bst[0] = 0u; bst[1] = 0u; }
    __syncthreads();
    XcdBarrier xbar = xcd_barrier_post((unsigned*)(p.ws + OFF_BAR), bst);
    bf16_t* WGU = (bf16_t*)(p.ws + OFF_WGU); bf16_t* WD = (bf16_t*)(p.ws + OFF_WD); bf16_t* WA = (bf16_t*)(p.ws + OFF_WA); bf16_t* WB = (bf16_t*)(p.ws + OFF_WB);
    bf16_t* WO = (bf16_t*)(p.ws + OFF_WO); bf16_t* TM = (bf16_t*)(p.ws + OFF_TM); bf16_t* H = (bf16_t*)(p.ws + OFF_H); bf16_t* Y = (bf16_t*)(p.ws + OFF_Y);
    bf16_t* HID = (bf16_t*)(p.ws + OFF_HID); bf16_t* PT = (bf16_t*)(p.ws + OFF_PT); bf16_t* Q = (bf16_t*)(p.ws + OFF_Q); bf16_t* YC = (bf16_t*)(p.ws + OFF_YCAT);

    for (int ph = p.ph_lo; ph < p.ph_hi; ++ph) {
        if (ph > p.ph_lo) { if (ph == p.ph_lo + 1) grid.sync(); else xcd_barrier(xbar); }
        if (ph == 0) {
            for (int rep = 0; rep < PREP_REPS; ++rep) {
            transpose_phase(p, lds, G);
            tm_phase(p, G);
            mcs_phase(p, lds, G);
            }
            norm_phase(nullptr, p.in[0], p.out, H, nullptr, p.in[1], 0.f, G);
            continue;
        }
        if (ph == 1) { for (int rep = 0; rep < FOLD_REPS; ++rep) fold_phase(p, lds, G); continue; }
        const int l = (ph - 2) / 10, s = (ph - 2) % 10;
        if (s == 0 || s == 7) {
            const int f = (s == 7);
            pg8::Gemm g{H, WGU + (size_t)(l * 2 + f) * 5632 * 1024, NTOK, 5632, 1024};
            pg8::Order S; S.init(NTOK, 5632, G, (int)blockIdx.x, 0);
            pg8::EpiSwiGLU E{HID, 0};
            for (int rep = 0; rep < GEMM_REPS; ++rep) { E.dry = (rep > 0 && p.ph_lo >= 0); pg8::gemm_phase<pg8::EpiSwiGLU, pg8::Order, true, true>(lds, g, S, E); }
        } else if (s == 2 || s == 6 || s == 9) {
            const float* gpost = (s == 2 ? p.in[5] : s == 6 ? p.in[12] : p.in[17]) + (size_t)l * DM;
            const float* gpre = (s == 2 ? p.in[6] + (size_t)l * DM : s == 6 ? p.in[13] + (size_t)l * DM : p.in[1] + (size_t)(l + 1) * DM);
            const bool fin = (s == 9 && l == NL - 1);
            for (int rep = 0; rep < NORM_REPS; ++rep) norm_phase(Y, p.out, rep < NORM_REPS - 1 ? (float*)HID : p.out, fin ? nullptr : H, gpost, gpre, s == 6 ? 1.0f : 0.5f, G);
        } else {
            const int nsub = (s == 3) ? 2 : 1;
            for (int sub = 0; sub < nsub; ++sub) {
                pg8::Gemm g; pg8::Order S; pg8::EpiMap E;
                if (s == 1 || s == 8) { const int f = (s == 8); g = pg8::Gemm{HID, WD + (size_t)(l * 2 + f) * 1024 * 2816, NTOK, 1024, 2816}; S.init(NTOK, 1024, G, (int)blockIdx.x, 0); E = pg8::EpiMap{Y, 1024, 0, 0}; }
                else if (s == 3 && sub == 0) { g = pg8::Gemm{WA + (size_t)l * 1024 * 1024, H, 1024, NTOK, 1024}; S.init(1024, NTOK, G, (int)blockIdx.x, 0); E = pg8::EpiMap{PT, 4096, 1, 0}; }
                else if (s == 3) { g = pg8::Gemm{H, WB + (size_t)l * 512 * 1024, NTOK, 512, 1024}; S.init(NTOK, 512, G, (int)blockIdx.x, 0); E = pg8::EpiMap{Q, 512, 0, 0}; }
                else if (s == 4) { g = pg8::Gemm{TM, PT, 2048, 8192, 4096}; S.init(2048, 8192, G, (int)blockIdx.x, 1); E = pg8::EpiMap{YC, 1024, 2, 0}; }
                else { g = pg8::Gemm{YC, WO + (size_t)l * 1024 * 1024, NTOK, 1024, 1024}; S.init(NTOK, 1024, G, (int)blockIdx.x, 0); E = pg8::EpiMap{Y, 1024, 0, 0}; }
                for (int rep = 0; rep < GEMM_REPS; ++rep) { E.dry = (rep > 0 && p.ph_lo >= 0); pg8::gemm_phase<pg8::EpiMap, pg8::Order, true, true>(lds, g, S, E); }
            }
            if (s == 4) for (int rep = 0; rep < POOL_REPS; ++rep) pool_phase(p, G);
        }
    }
}

extern "C" void kernel_launch(void* const* d_in, const int* in_sizes, int n_in, void* d_out, int out_size, void* d_ws, size_t ws_size, hipStream_t stream) {
    static int grid = 0;
    if (grid == 0) {
        if (n_in != 18 || out_size != NTOK * DM || ws_size < WS_END) { fprintf(stderr, "kernel_launch: unexpected shapes (n_in %d out %d ws %zu need %zu)\n", n_in, out_size, ws_size, (size_t)WS_END); grid = -1; return; }
        int dev = 0, cus = 0, per_cu = 0;
        hipGetDevice(&dev); hipDeviceGetAttribute(&cus, hipDeviceAttributeMultiprocessorCount, dev);
        if (hipFuncSetAttribute((const void*)fwd_kernel, hipFuncAttributeMaxDynamicSharedMemorySize, LDS_BYTES) != hipSuccess) { fprintf(stderr, "kernel_launch: hipFuncSetAttribute failed\n"); grid = -1; return; }
        if (hipOccupancyMaxActiveBlocksPerMultiprocessor(&per_cu, (const void*)fwd_kernel, NTHREADS, LDS_BYTES) != hipSuccess || per_cu < 1) { fprintf(stderr, "kernel_launch: occupancy query says %d\n", per_cu); per_cu = 1; }
        (void)hipGetLastError();
        grid = cus * per_cu;
        fprintf(stderr, "kernel_launch: grid %d (cus %d x %d)\n", grid, cus, per_cu);
    }
    if (grid < 0) return;
    if (hipMemsetAsync((char*)d_ws + OFF_BAR, 0, SZ_BAR, stream) != hipSuccess) { fprintf(stderr, "kernel_launch: memset failed\n"); return; }
    Params p{};
    for (int i = 0; i < 18; ++i) p.in[i] = (const float*)d_in[i];
    p.out = (float*)d_out; p.ws = (unsigned char*)d_ws;
#if MULTI_LAUNCH
    for (int ph = 0; ph < NPHASES; ++ph) { p.ph_lo = ph; p.ph_hi = ph + 1; hipLaunchKernelGGL(fwd_kernel, dim3(grid), dim3(NTHREADS), LDS_BYTES, stream, p); }
#else
    p.ph_lo = 0; p.ph_hi = NPHASES;
    void* args[] = {&p};
    hipError_t e = hipLaunchCooperativeKernel((const void*)fwd_kernel, dim3(grid), dim3(NTHREADS), args, LDS_BYTES, stream);
    if (e != hipSuccess) fprintf(stderr, "kernel_launch: cooperative launch failed: %s (grid %d)\n", hipGetErrorString(e), grid);
#endif
}
```

```cpp
#include <hip/hip_runtime.h>
#include <hip/hip_cooperative_groups.h>
#include <cstdio>
#include <cstdint>
namespace cg = cooperative_groups;

#ifndef GEMM_REPS
#define GEMM_REPS 1
#endif
#ifndef NORM_REPS
#define NORM_REPS 1
#endif
#ifndef POOL_REPS
#define POOL_REPS 1
#endif
#ifndef FOLD_REPS
#define FOLD_REPS 1
#endif
#ifndef PREP_REPS
#define PREP_REPS 1
#endif
#ifndef MULTI_LAUNCH
#define MULTI_LAUNCH 0
#endif

#define LAS __attribute__((address_space(3)))
typedef unsigned short bf16_t;
typedef short bf16x8 __attribute__((ext_vector_type(8)));
typedef float f32x4 __attribute__((ext_vector_type(4)));
typedef unsigned u32x4 __attribute__((ext_vector_type(4)));
typedef unsigned u32x2 __attribute__((ext_vector_type(2)));

__device__ __forceinline__ int tid_opaque() { int t; asm volatile("v_mov_b32 %0, %1" : "=v"(t) : "v"(threadIdx.x)); return t; }

constexpr int NTOK = 32768, DM = 1024, FF = 2816, NL = 4, SEQ = 2048, NB = 16;
constexpr float EPS = 1e-6f;
constexpr int NTHREADS = 512;
constexpr int LDS_STAGE = 131072;
constexpr int LDS_BYTES = LDS_STAGE + 16;

constexpr size_t SZ_WGU = (size_t)NL * 2 * 5632 * 1024 * 2;
constexpr size_t SZ_WD = (size_t)NL * 2 * 1024 * 2816 * 2;
constexpr size_t SZ_WA = (size_t)NL * 1024 * 1024 * 2;
constexpr size_t SZ_WB = (size_t)NL * 512 * 1024 * 2;
constexpr size_t SZ_WO = (size_t)NL * 1024 * 1024 * 2;
constexpr size_t SZ_TM = (size_t)2048 * 2048 * 2;
constexpr size_t SZ_MCS = (size_t)NL * 4 * 128 * 256 * 4;
constexpr size_t SZ_H = (size_t)NTOK * 1024 * 2;
constexpr size_t SZ_Y = (size_t)NTOK * 1024 * 2;
constexpr size_t SZ_HID = (size_t)NTOK * 2816 * 2;
constexpr size_t OFF_WGU = 0;
constexpr size_t OFF_WD = OFF_WGU + SZ_WGU;
constexpr size_t OFF_WA = OFF_WD + SZ_WD;
constexpr size_t OFF_WB = OFF_WA + SZ_WA;
constexpr size_t OFF_WO = OFF_WB + SZ_WB;
constexpr size_t OFF_TM = OFF_WO + SZ_WO;
constexpr size_t OFF_MCS = OFF_TM + SZ_TM;
constexpr size_t OFF_H = OFF_MCS + SZ_MCS;
constexpr size_t OFF_Y = OFF_H + SZ_H;
constexpr size_t OFF_HID = OFF_Y + SZ_Y;
constexpr size_t OFF_PT = OFF_HID;
constexpr size_t SZ_PT = (size_t)NB * 512 * 2048 * 2;
constexpr size_t OFF_Q = OFF_PT + SZ_PT;
constexpr size_t SZ_Q = (size_t)NTOK * 512 * 2;
constexpr size_t OFF_YCAT = OFF_Q + SZ_Q;
constexpr size_t SZ_YCAT = (size_t)NTOK * 1024 * 2;
constexpr size_t OFF_HF = OFF_YCAT;
constexpr size_t SZ_HF = (size_t)2 * NB * 1024 * 1024 * 2;
constexpr size_t OFF_BAR = OFF_HID + SZ_HID;
constexpr size_t SZ_BAR = 16384;
constexpr size_t OFF_NYQ = OFF_BAR + SZ_BAR;
constexpr size_t SZ_NYQ = (size_t)NB * 512 * 4;
constexpr size_t WS_END = OFF_NYQ + SZ_NYQ;
static_assert(OFF_YCAT + SZ_YCAT <= OFF_BAR && OFF_HF + SZ_HF <= OFF_BAR, "alias region");

struct Params { const float* in[18]; float* out; unsigned char* ws; int ph_lo, ph_hi; };

namespace pg8 {
constexpr int BM = 256, BK = 64, HALF = 128, HTB = HALF * BK * 2, STAGE_BYTES = 8 * HTB, NXCD = 8, WGM = 8;
__host__ __device__ __forceinline__ int lds_byte(int r, int c) { const int st = (r >> 4) * 2 + (c >> 5), rr = r & 15, cc = c & 31, ob = rr * 64 + cc * 2; return st * 1024 + (ob ^ (((ob >> 9) & 1) << 5)); }
__host__ __device__ __forceinline__ void stage_rc(int b, int& R, int& C) { const int st = b / 1024, sb = b % 1024, swz = sb ^ (((sb >> 9) & 1) << 5); R = (st >> 1) * 16 + swz / 64; C = (st & 1) * 32 + (swz % 64) / 2; }
__host__ __device__ __forceinline__ int perm32(int rho) { const int n = rho >> 4, i = rho & 15; return 8 * (i >> 2) + 4 * n + (i & 3); }

struct Unit { int pm, pn; };
struct Gemm { const bf16_t* A; const bf16_t* Bt; int M, N, K; };

struct Order {
    int nM, nN, nwg, G, c, mode;
    __device__ void init(int M, int N, int G_, int c_, int mode_) { nM = M / BM; nN = N / BM; nwg = (mode_ == 2) ? 256 : nM * nN; G = G_; c = c_; mode = mode_; }
    __device__ bool next(int i, Unit& u) const {
        const long L = (long)i * G + c; if (L >= nwg) return false;
        if (mode == 1) { const int xcd = (int)L & 7, j = (int)L >> 3; const int b = 2 * xcd + (j >> 4); u.pn = b * 2 + ((j >> 3) & 1); u.pm = j & 7; return true; }
        if (mode == 2) { const int uu = ((int)L & 7) * 32 + ((int)L >> 3), part = uu >> 7, j = uu & 127; u.pm = part * 2 + (j & 1); u.pn = part * 64 + (j >> 1); return true; }
        int wgid = (int)L; { const int q = nwg / NXCD, r = nwg % NXCD, xcd = wgid % NXCD, off = wgid / NXCD; wgid = (xcd < r ? xcd * (q + 1) : r * (q + 1) + (xcd - r) * q) + off; }
        const int nig = WGM * nN, gid = wgid / nig, fm = gid * WGM, gsz = (nM - fm) < WGM ? (nM - fm) : WGM;
        u.pm = fm + ((wgid % nig) % gsz); u.pn = (wgid % nig) / gsz; return true;
    }
    __device__ __forceinline__ void a_ready(const Unit&) const {}
    __device__ __forceinline__ void done(const Unit&) const {}
};

__device__ __forceinline__ unsigned cvt_pk_bf16(float lo, float hi) { unsigned r; asm volatile("v_cvt_pk_bf16_f32 %0, %1, %2" : "=v"(r) : "v"(lo), "v"(hi)); return r; }

struct EpiMap {
    static constexpr bool PERM = true, AFTER_DRAIN = false;
    bf16_t* O; int ldc; int mode; int dry; const float* nyq;
    __device__ __forceinline__ void operator()(const f32x4 (&acc)[2][2][4][2], const Unit& u, int wr, int wc, int fr, int fq) const {
        if (dry) return;
        size_t tb; int ld = ldc;
        if (mode == 0) tb = (size_t)u.pm * 256 * (size_t)ldc + (size_t)u.pn * 256;
        else if (mode == 1) { const int pnl = u.pn & 63; tb = ((size_t)((pnl >> 2) * 512 + (u.pm & 1) * 256)) * 2048 + (size_t)((u.pm >> 1) * 1024 + (pnl & 3) * 256); ld = 2048; }
        else { tb = ((size_t)((u.pn >> 1) * 2048 + u.pm * 256)) * 1024 + (size_t)((u.pn & 1) * 256); ld = 1024; }
        bf16_t* base = O + tb + (size_t)(wr * 64 + fr) * ld + wc * 32 + 8 * fq;
#pragma unroll
        for (int ai = 0; ai < 2; ++ai)
#pragma unroll
            for (int m = 0; m < 4; ++m) { bf16_t* rowp = base + (size_t)(ai * HALF + m * 16) * ld;
#pragma unroll
                for (int bj = 0; bj < 2; ++bj) { f32x4 v0 = acc[ai][bj][m][0], v1 = acc[ai][bj][m][1];
                    if (mode == 2) { const float* q = nyq + (u.pn >> 1) * 512 + (u.pn & 1) * 256 + bj * HALF + wc * 32 + 8 * fq; const float sg = (fr & 1) ? (-1.0f / 512.0f) : (1.0f / 512.0f);
                        v0 += *(const f32x4*)q * sg; v1 += *(const f32x4*)(q + 4) * sg; }
                    u32x4 w; w.x = cvt_pk_bf16(v0[0], v0[1]); w.y = cvt_pk_bf16(v0[2], v0[3]); w.z = cvt_pk_bf16(v1[0], v1[1]); w.w = cvt_pk_bf16(v1[2], v1[3]);
                    *(u32x4*)(rowp + bj * HALF) = w; } }
    }
};
__device__ __forceinline__ float silu_mul(float a, float b) { return a * __builtin_amdgcn_rcpf(1.0f + __expf(-a)) * b; }
struct EpiSwiGLU {
    static constexpr bool PERM = true, AFTER_DRAIN = false;
    bf16_t* O; int dry;
    __device__ __forceinline__ void operator()(const f32x4 (&acc)[2][2][4][2], const Unit& u, int wr, int wc, int fr, int fq) const {
        if (dry) return;
        bf16_t* base = O + (size_t)(u.pm * 256 + wr * 64 + fr) * FF + u.pn * 128 + wc * 32 + 8 * fq;
#pragma unroll
        for (int ai = 0; ai < 2; ++ai)
#pragma unroll
            for (int m = 0; m < 4; ++m) { bf16_t* rowp = base + (size_t)(ai * HALF + m * 16) * FF;
                const f32x4 g0 = acc[ai][0][m][0], g1 = acc[ai][0][m][1], u0 = acc[ai][1][m][0], u1 = acc[ai][1][m][1];
                u32x4 w; w.x = cvt_pk_bf16(silu_mul(g0[0], u0[0]), silu_mul(g0[1], u0[1])); w.y = cvt_pk_bf16(silu_mul(g0[2], u0[2]), silu_mul(g0[3], u0[3]));
                w.z = cvt_pk_bf16(silu_mul(g1[0], u1[0]), silu_mul(g1[1], u1[1])); w.w = cvt_pk_bf16(silu_mul(g1[2], u1[2]), silu_mul(g1[3], u1[3]));
                *(u32x4*)rowp = w; }
    }
};

template <class Epi, class Sched, bool ALIGN_EPI = false, bool SP2 = false>
__device__ __forceinline__ void gemm_phase(LAS unsigned char* lds, const Gemm g, const Sched& S, const Epi& E) {
    const int tid = tid_opaque(), wid = __builtin_amdgcn_readfirstlane(tid >> 6), lane = tid & 63, wr = wid >> 2, wc = wid & 3, fr = lane & 15, fq = lane >> 4;
    const int K = g.K, nt = K / BK;
    unsigned voffA[2], voffB[2];
#pragma unroll
    for (int i = 0; i < 2; ++i) { int R, C; stage_rc(tid * 16 + i * 8192, R, C); const int Rb = Epi::PERM ? ((R & ~31) + perm32(R & 31)) : R;
        voffA[i] = (unsigned)(R * K + C) * 2u; voffB[i] = (unsigned)(Rb * K + C) * 2u; }
    const size_t kstep = (size_t)(BK * 2);
    const size_t hstep = (size_t)HALF * K * 2;
    const size_t tstep = 2 * hstep;
    const unsigned ldsw = (unsigned)wid * 1024u;
    const int aoff = lds_byte(wr * 64 + fr, fq * 8), boff = lds_byte(wc * 32 + fr, fq * 8);
#define PG8_SA(b, h) (((b) * 2 + (h)) * HTB)
#define PG8_SB(b, h) ((4 + (b) * 2 + (h)) * HTB)
#define PG8_STAGE(bufoff, gbase, voff) do { _Pragma("unroll") for (int _i = 0; _i < 2; ++_i) \
        __builtin_amdgcn_global_load_lds((const unsigned*)((const char*)(gbase) + (voff)[_i]), (LAS unsigned*)(lds + (bufoff) + ldsw + _i * 8192), 16, 0, 0); } while (0)
#define PG8_LDA(dst, b, h) do { _Pragma("unroll") for (int m = 0; m < 4; ++m) _Pragma("unroll") for (int k = 0; k < 2; ++k) dst[m][k] = *(const LAS bf16x8*)(lds + PG8_SA(b, h) + aoff + m * 2048 + k * 1024); } while (0)
#define PG8_LDB(dst, b, h) do { _Pragma("unroll") for (int n = 0; n < 2; ++n) _Pragma("unroll") for (int k = 0; k < 2; ++k) dst[n][k] = *(const LAS bf16x8*)(lds + PG8_SB(b, h) + boff + n * 2048 + k * 1024); } while (0)
#define PG8_MMA(ai, bj, At, Bt) do { __builtin_amdgcn_s_setprio(1); _Pragma("unroll") for (int m = 0; m < 4; ++m) _Pragma("unroll") for (int n = 0; n < 2; ++n) _Pragma("unroll") for (int k = 0; k < 2; ++k) \
        acc[ai][bj][m][n] = __builtin_amdgcn_mfma_f32_16x16x32_bf16(Bt[n][k], At[m][k], acc[ai][bj][m][n], 0, 0, 0); __builtin_amdgcn_s_setprio(0); } while (0)
#define PG8_WAIT_V(n) asm volatile("s_waitcnt vmcnt(" #n ")" ::: "memory")
#define PG8_WAIT_L(n) asm volatile("s_waitcnt lgkmcnt(" #n ")" ::: "memory")
#define PG8_BAR __builtin_amdgcn_s_barrier()
#define PG8_SCHED __builtin_amdgcn_sched_barrier(0)
    Unit cur, nxt; int ui = 0;
    if (!S.next(0, cur)) return;
    f32x4 acc[2][2][4][2];
#pragma unroll
    for (int a = 0; a < 2; ++a)
#pragma unroll
        for (int b = 0; b < 2; ++b)
#pragma unroll
            for (int m = 0; m < 4; ++m)
#pragma unroll
                for (int n = 0; n < 2; ++n) acc[a][b][m][n] = (f32x4){0.f, 0.f, 0.f, 0.f};
    bf16x8 At[4][2], B0[2][2], B1[2][2];
    const char* cA = (const char*)g.A + (size_t)cur.pm * tstep; const char* cB = (const char*)g.Bt + (size_t)cur.pn * tstep;
    S.a_ready(cur);
    if constexpr (SP2) {
        PG8_STAGE(PG8_SB(0, 0), cB, voffB); PG8_STAGE(PG8_SB(0, 1), cB + hstep, voffB); PG8_STAGE(PG8_SA(0, 0), cA, voffA); PG8_STAGE(PG8_SA(0, 1), cA + hstep, voffA);
        if (wr == 1) PG8_BAR;
        PG8_WAIT_V(2); PG8_BAR;
        PG8_STAGE(PG8_SB(1, 0), cB + kstep, voffB); PG8_STAGE(PG8_SA(1, 0), cA + kstep, voffA); PG8_STAGE(PG8_SB(1, 1), cB + hstep + kstep, voffB);
        PG8_WAIT_V(6); PG8_BAR;
    } else {
        PG8_STAGE(PG8_SB(0, 0), cB, voffB); PG8_STAGE(PG8_SA(0, 0), cA, voffA); PG8_STAGE(PG8_SB(0, 1), cB + hstep, voffB); PG8_STAGE(PG8_SA(0, 1), cA + hstep, voffA);
        if (wr == 1) PG8_BAR;
        PG8_WAIT_V(4); PG8_BAR;
        PG8_STAGE(PG8_SB(1, 0), cB + kstep, voffB); PG8_STAGE(PG8_SA(1, 0), cA + kstep, voffA); PG8_STAGE(PG8_SB(1, 1), cB + hstep + kstep, voffB);
        PG8_WAIT_V(6); PG8_BAR;
    }
    for (;;) {
        const bool has_next = S.next(ui + 1, nxt);
        const char* nA = has_next ? (const char*)g.A + (size_t)nxt.pm * tstep : cA; const char* nB = has_next ? (const char*)g.Bt + (size_t)nxt.pn * tstep : cB;
        for (int t = 0; t < nt; t += 2) {
            const bool last = (t == nt - 2);
            const char* a1 = cA + (size_t)(t + 1) * kstep;
            const char* a2 = last ? nA : cA + (size_t)(t + 2) * kstep; const char* b2 = last ? nB : cB + (size_t)(t + 2) * kstep;
            const char* a3 = a2 + kstep; const char* b3 = b2 + kstep;
            if (last && has_next) S.a_ready(nxt);
            if constexpr (SP2) {
            PG8_LDB(B0, 0, 0); PG8_LDB(B1, 0, 1); PG8_SCHED; PG8_LDA(At, 0, 0); PG8_STAGE(PG8_SA(1, 1), a1 + hstep, voffA);
            PG8_WAIT_V(8); PG8_WAIT_L(0); PG8_BAR; PG8_MMA(0, 0, At, B0); PG8_MMA(0, 1, At, B1); PG8_BAR; PG8_SCHED;
            PG8_LDA(At, 0, 1); PG8_STAGE(PG8_SB(0, 0), b2, voffB); PG8_STAGE(PG8_SB(0, 1), b2 + hstep, voffB); PG8_STAGE(PG8_SA(0, 0), a2, voffA);
            PG8_WAIT_V(8); PG8_WAIT_L(0); PG8_BAR; PG8_MMA(1, 0, At, B0); PG8_MMA(1, 1, At, B1); PG8_BAR; PG8_SCHED;
            PG8_LDB(B0, 1, 0); PG8_LDB(B1, 1, 1); PG8_SCHED; PG8_LDA(At, 1, 0); PG8_STAGE(PG8_SA(0, 1), a2 + hstep, voffA);
            PG8_WAIT_V(8); PG8_WAIT_L(0); PG8_BAR; PG8_MMA(0, 0, At, B0); PG8_MMA(0, 1, At, B1); PG8_BAR; PG8_SCHED;
            PG8_LDA(At, 1, 1); PG8_STAGE(PG8_SB(1, 0), b3, voffB); PG8_STAGE(PG8_SB(1, 1), b3 + hstep, voffB); PG8_STAGE(PG8_SA(1, 0), a3, voffA);
            PG8_WAIT_V(8); PG8_WAIT_L(0); PG8_BAR; PG8_MMA(1, 0, At, B0); PG8_MMA(1, 1, At, B1); PG8_BAR; PG8_SCHED;
            } else {
            PG8_LDB(B0, 0, 0); PG8_SCHED; PG8_LDA(At, 0, 0); PG8_STAGE(PG8_SA(1, 1), a1 + hstep, voffA);
            PG8_WAIT_L(8); PG8_BAR; PG8_WAIT_L(0); PG8_MMA(0, 0, At, B0); PG8_BAR; PG8_SCHED;
            PG8_LDB(B1, 0, 1); PG8_STAGE(PG8_SB(0, 0), b2, voffB);
            PG8_BAR; PG8_WAIT_L(0); PG8_MMA(0, 1, At, B1); PG8_BAR;
            PG8_LDA(At, 0, 1); PG8_STAGE(PG8_SA(0, 0), a2, voffA);
            PG8_BAR; PG8_WAIT_L(0); PG8_MMA(1, 0, At, B0); PG8_BAR; PG8_SCHED;
            PG8_STAGE(PG8_SB(0, 1), b2 + hstep, voffB);
            PG8_WAIT_V(6); PG8_BAR; PG8_MMA(1, 1, At, B1); PG8_BAR;
            PG8_LDB(B0, 1, 0); PG8_SCHED; PG8_LDA(At, 1, 0); PG8_STAGE(PG8_SA(0, 1), a2 + hstep, voffA);
            PG8_WAIT_L(8); PG8_BAR; PG8_WAIT_L(0); PG8_MMA(0, 0, At, B0); PG8_BAR; PG8_SCHED;
            PG8_LDB(B1, 1, 1); PG8_STAGE(PG8_SB(1, 0), b3, voffB);
            PG8_BAR; PG8_WAIT_L(0); PG8_MMA(0, 1, At, B1); PG8_BAR;
            PG8_LDA(At, 1, 1); PG8_STAGE(PG8_SA(1, 0), a3, voffA);
            PG8_BAR; PG8_WAIT_L(0); PG8_MMA(1, 0, At, B0); PG8_BAR; PG8_SCHED;
            PG8_STAGE(PG8_SB(1, 1), b3 + hstep, voffB);
            PG8_WAIT_V(6); PG8_BAR; PG8_MMA(1, 1, At, B1); PG8_BAR;
            }
        }
        if constexpr (ALIGN_EPI) { if (wr == 0) PG8_BAR; }
        if constexpr (!Epi::AFTER_DRAIN) { E(acc, cur, wr, wc, fr, fq); S.done(cur); }
        if (!has_next) break;
#pragma unroll
        for (int a = 0; a < 2; ++a)
#pragma unroll
            for (int b = 0; b < 2; ++b)
#pragma unroll
                for (int m = 0; m < 4; ++m)
#pragma unroll
                    for (int n = 0; n < 2; ++n) acc[a][b][m][n] = (f32x4){0.f, 0.f, 0.f, 0.f};
        cur = nxt; cA = nA; cB = nB; ++ui;
        if constexpr (ALIGN_EPI) { if (wr == 1) PG8_BAR; }
    }
    PG8_WAIT_V(0);
    if constexpr (!ALIGN_EPI) { if (wr == 0) PG8_BAR; }
    PG8_BAR;
#undef PG8_SA
#undef PG8_SB
#undef PG8_STAGE
#undef PG8_LDA
#undef PG8_LDB
#undef PG8_MMA
#undef PG8_WAIT_V
#undef PG8_WAIT_L
#undef PG8_BAR
#undef PG8_SCHED
}
}

__device__ __forceinline__ float wave_sum(float v) {
    v += __shfl_xor(v, 32); v += __shfl_xor(v, 16); v += __shfl_xor(v, 8); v += __shfl_xor(v, 4); v += __shfl_xor(v, 2); v += __shfl_xor(v, 1); return v;
}
__device__ __forceinline__ float bf_lo(unsigned u) { return __uint_as_float(u << 16); }
__device__ __forceinline__ float bf_hi(unsigned u) { return __uint_as_float(u & 0xffff0000u); }

struct NormRows { f32x4 x0[4], x1[4]; u32x2 y0[4], y1[4]; };
__device__ __forceinline__ void norm_rows_of(int q, bool fold, int& r0, int& r1) {
    if (fold) { const int b = q >> 10, k = q & 1023; r0 = b * SEQ + k; r1 = b * SEQ + (k == 0 ? SEQ / 2 : SEQ - k); }
    else { r0 = q; r1 = q + NTOK / 2; }
}
__device__ __forceinline__ void norm_load(NormRows& r, const bf16_t* y, const float* xin, int r0, int r1, int lane, bool has_y) {
    const size_t o0 = (size_t)r0 * DM + lane * 4, o1 = (size_t)r1 * DM + lane * 4;
#pragma unroll
    for (int j = 0; j < 4; ++j) { r.x0[j] = __builtin_nontemporal_load((const f32x4*)(xin + o0 + 256 * j)); r.x1[j] = __builtin_nontemporal_load((const f32x4*)(xin + o1 + 256 * j)); }
    if (has_y) {
#pragma unroll
        for (int j = 0; j < 4; ++j) { r.y0[j] = __builtin_nontemporal_load((const u32x2*)(y + o0 + 256 * j)); r.y1[j] = __builtin_nontemporal_load((const u32x2*)(y + o1 + 256 * j)); }
    }
}
__device__ __forceinline__ void norm_phase(const bf16_t* y, const float* xin, float* xout, bf16_t* h, bf16_t* hf, const float* gpost, const float* gpre, float coef, int G) {
    const int tid = tid_opaque(); const int lane = tid & 63, wid = tid >> 6;
    const int gw = blockIdx.x * 8 + wid, nw = G * 8;
    const bool has_y = (y != nullptr), has_h = (h != nullptr), fold = (hf != nullptr);
    f32x4 gp[4], gq[4];
#pragma unroll
    for (int j = 0; j < 4; ++j) {
        gp[j] = has_y ? *(const f32x4*)(gpost + lane * 4 + 256 * j) : (f32x4){0.f, 0.f, 0.f, 0.f};
        gq[j] = has_h ? *(const f32x4*)(gpre + lane * 4 + 256 * j) : (f32x4){0.f, 0.f, 0.f, 0.f};
    }
    NormRows cur, nxt;
    int r0, r1;
    if (gw < NTOK / 2) { norm_rows_of(gw, fold, r0, r1); norm_load(cur, y, xin, r0, r1, lane, has_y); }
    for (int q = gw; q < NTOK / 2; q += nw) {
        norm_rows_of(q, fold, r0, r1);
        if (q + nw < NTOK / 2) { int n0, n1; norm_rows_of(q + nw, fold, n0, n1); norm_load(nxt, y, xin, n0, n1, lane, has_y); }
        const size_t o0 = (size_t)r0 * DM + lane * 4, o1 = (size_t)r1 * DM + lane * 4;
        f32x4 x0[4], x1[4];
#pragma unroll
        for (int j = 0; j < 4; ++j) { x0[j] = cur.x0[j]; x1[j] = cur.x1[j]; }
        if (has_y) {
            f32x4 v0[4], v1[4]; float s0 = 0.f, s1 = 0.f;
#pragma unroll
            for (int j = 0; j < 4; ++j) {
                v0[j] = (f32x4){bf_lo(cur.y0[j].x), bf_hi(cur.y0[j].x), bf_lo(cur.y0[j].y), bf_hi(cur.y0[j].y)};
                v1[j] = (f32x4){bf_lo(cur.y1[j].x), bf_hi(cur.y1[j].x), bf_lo(cur.y1[j].y), bf_hi(cur.y1[j].y)};
                s0 += (v0[j][0] * v0[j][0] + v0[j][1] * v0[j][1]) + (v0[j][2] * v0[j][2] + v0[j][3] * v0[j][3]);
                s1 += (v1[j][0] * v1[j][0] + v1[j][1] * v1[j][1]) + (v1[j][2] * v1[j][2] + v1[j][3] * v1[j][3]);
            }
            s0 = wave_sum(s0); s1 = wave_sum(s1);
            const float c0 = coef * rsqrtf(s0 * (1.0f / DM) + EPS), c1 = coef * rsqrtf(s1 * (1.0f / DM) + EPS);
#pragma unroll
            for (int j = 0; j < 4; ++j) { x0[j] += v0[j] * gp[j] * c0; x1[j] += v1[j] * gp[j] * c1; }
        }
#pragma unroll
        for (int j = 0; j < 4; ++j) { *(f32x4*)(xout + o0 + 256 * j) = x0[j]; *(f32x4*)(xout + o1 + 256 * j) = x1[j]; }
        if (has_h) {
            float s0 = 0.f, s1 = 0.f;
#pragma unroll
            for (int j = 0; j < 4; ++j) {
                s0 += (x0[j][0] * x0[j][0] + x0[j][1] * x0[j][1]) + (x0[j][2] * x0[j][2] + x0[j][3] * x0[j][3]);
                s1 += (x1[j][0] * x1[j][0] + x1[j][1] * x1[j][1]) + (x1[j][2] * x1[j][2] + x1[j][3] * x1[j][3]);
            }
            s0 = wave_sum(s0); s1 = wave_sum(s1);
            const float c0 = rsqrtf(s0 * (1.0f / DM) + EPS), c1 = rsqrtf(s1 * (1.0f / DM) + EPS);
            const int kf = q & 1023; const float fs = (kf == 0) ? 0.f : 1.f;
            const size_t oe = ((size_t)(q >> 10) * 1024 + kf) * DM + lane * 4, oo = oe + (size_t)NB * 1024 * DM;
#pragma unroll
            for (int j = 0; j < 4; ++j) {
                const f32x4 a = x0[j] * gq[j] * c0, b = x1[j] * gq[j] * c1;
                u32x2 wa, wb; wa.x = pg8::cvt_pk_bf16(a[0], a[1]); wa.y = pg8::cvt_pk_bf16(a[2], a[3]); wb.x = pg8::cvt_pk_bf16(b[0], b[1]); wb.y = pg8::cvt_pk_bf16(b[2], b[3]);
                *(u32x2*)(h + o0 + 256 * j) = wa; *(u32x2*)(h + o1 + 256 * j) = wb;
                if (fold) { const f32x4 e = a + b * fs, o = (a - b) * fs;
                    u32x2 we, wo; we.x = pg8::cvt_pk_bf16(e[0], e[1]); we.y = pg8::cvt_pk_bf16(e[2], e[3]); wo.x = pg8::cvt_pk_bf16(o[0], o[1]); wo.y = pg8::cvt_pk_bf16(o[2], o[3]);
                    *(u32x2*)(hf + oe + 256 * j) = we; *(u32x2*)(hf + oo + 256 * j) = wo; }
            }
        }
        cur = nxt;
    }
}

__device__ __forceinline__ void transpose_phase(const Params& p, LAS unsigned char* lds, int G) {
    LAS float* T = (LAS float*)lds;
    const int tid = tid_opaque();
    constexpr int TPL = 4480;
    const int nrounds = NL * TPL / 4;
    bf16_t* WGU = (bf16_t*)(p.ws + OFF_WGU); bf16_t* WD = (bf16_t*)(p.ws + OFF_WD); bf16_t* WO = (bf16_t*)(p.ws + OFF_WO);
    for (int R = blockIdx.x; R < nrounds; R += G) {
        const int ti0 = R * 4, l = ti0 / TPL, r = ti0 % TPL; int m = r / 704; if (m > 6) m = 6; const int t0 = r - m * 704;
        const float* src; int N, tn; bf16_t* dst; int ldd, kind;
        if (m == 0) { src = p.in[2] + (size_t)l * 1024 * 2816; N = 2816; tn = 44; dst = WGU + (size_t)(l * 2 + 0) * 5632 * 1024; ldd = 1024; kind = 0; }
        else if (m == 1) { src = p.in[3] + (size_t)l * 1024 * 2816; N = 2816; tn = 44; dst = WGU + (size_t)(l * 2 + 0) * 5632 * 1024; ldd = 1024; kind = 1; }
        else if (m == 2) { src = p.in[4] + (size_t)l * 2816 * 1024; N = 1024; tn = 16; dst = WD + (size_t)(l * 2 + 0) * 1024 * 2816; ldd = 2816; kind = 2; }
        else if (m == 3) { src = p.in[14] + (size_t)l * 1024 * 2816; N = 2816; tn = 44; dst = WGU + (size_t)(l * 2 + 1) * 5632 * 1024; ldd = 1024; kind = 0; }
        else if (m == 4) { src = p.in[15] + (size_t)l * 1024 * 2816; N = 2816; tn = 44; dst = WGU + (size_t)(l * 2 + 1) * 5632 * 1024; ldd = 1024; kind = 1; }
        else if (m == 5) { src = p.in[16] + (size_t)l * 2816 * 1024; N = 1024; tn = 16; dst = WD + (size_t)(l * 2 + 1) * 1024 * 2816; ldd = 2816; kind = 2; }
        else { src = p.in[11] + (size_t)l * 1024 * 1024; N = 1024; tn = 16; dst = WO + (size_t)l * 1024 * 1024; ldd = 1024; kind = 2; }
        f32x4 v[4][2];
#pragma unroll
        for (int q = 0; q < 4; ++q) { const int t = t0 + q, kt = t / tn, ntile = t - kt * tn;
#pragma unroll
            for (int i = 0; i < 2; ++i) v[q][i] = *(const f32x4*)(src + (size_t)(kt * 64 + (tid >> 4) + 32 * i) * N + ntile * 64 + (tid & 15) * 4); }
#pragma unroll
        for (int q = 0; q < 4; ++q)
#pragma unroll
            for (int i = 0; i < 2; ++i) { LAS float* d = T + q * 4160 + ((tid >> 4) + 32 * i) * 65 + (tid & 15) * 4; d[0] = v[q][i][0]; d[1] = v[q][i][1]; d[2] = v[q][i][2]; d[3] = v[q][i][3]; }
        __syncthreads();
#pragma unroll
        for (int q = 0; q < 4; ++q) { const int t = t0 + q, kt = t / tn, ntile = t - kt * tn;
            const int nl = tid >> 3, k8 = (tid & 7) * 8; const int n = ntile * 64 + nl;
            const int drow = (kind == 2) ? n : ((n >> 7) * 256 + (n & 127) + (kind == 1 ? 128 : 0));
            const LAS float* s = T + q * 4160 + k8 * 65 + nl;
            u32x4 w; w.x = pg8::cvt_pk_bf16(s[0], s[65]); w.y = pg8::cvt_pk_bf16(s[130], s[195]); w.z = pg8::cvt_pk_bf16(s[260], s[325]); w.w = pg8::cvt_pk_bf16(s[390], s[455]);
            *(u32x4*)(dst + (size_t)drow * ldd + kt * 64 + k8) = w; }
        __syncthreads();
    }
}

__device__ __forceinline__ void tm_phase(const Params& p, int G) {
    bf16_t* TM = (bf16_t*)(p.ws + OFF_TM);
    const int total = 2048 * 2048 / 8; const int tid = tid_opaque();
    for (int e = blockIdx.x * NTHREADS + tid; e < total; e += G * NTHREADS) {
        const int s = e >> 8, k0 = (e & 255) * 8; float v[8];
#pragma unroll
        for (int j = 0; j < 8; ++j) { const int k = k0 + j, kk = k & 1023; const int ph = (s * kk) & 2047; const float a = (float)ph * (1.0f / 1024.0f);
            v[j] = (k < 1024) ? cospif(a) * (1.0f / 512.0f) : -sinpif(a) * (1.0f / 512.0f); }
        u32x4 w; w.x = pg8::cvt_pk_bf16(v[0], v[1]); w.y = pg8::cvt_pk_bf16(v[2], v[3]); w.z = pg8::cvt_pk_bf16(v[4], v[5]); w.w = pg8::cvt_pk_bf16(v[6], v[7]);
        *(u32x4*)(TM + (size_t)e * 8) = w;
    }
}

__device__ __forceinline__ void nyq_phase(const bf16_t* WA, const bf16_t* H, float* nyq, int G) {
    const int tid = tid_opaque(), lane = tid & 63, wid = tid >> 6;
    for (int t = blockIdx.x * 8 + wid; t < NB * 512; t += G * 8) {
        const int b = t >> 9, n = t & 511;
        const bf16_t* w = WA + (size_t)n * 1024 + lane * 8; const bf16_t* h = H + ((size_t)b * SEQ + 1024) * 1024 + lane * 8;
        float acc = 0.f;
#pragma unroll
        for (int j = 0; j < 2; ++j) { const u32x4 a = *(const u32x4*)(w + 512 * j), c = *(const u32x4*)(h + 512 * j);
            acc += bf_lo(a.x) * bf_lo(c.x) + bf_hi(a.x) * bf_hi(c.x) + bf_lo(a.y) * bf_lo(c.y) + bf_hi(a.y) * bf_hi(c.y) + bf_lo(a.z) * bf_lo(c.z) + bf_hi(a.z) * bf_hi(c.z) + bf_lo(a.w) * bf_lo(c.w) + bf_hi(a.w) * bf_hi(c.w); }
        acc = wave_sum(acc);
        if (lane == 0) nyq[t] = acc;
    }
}

__device__ __forceinline__ void mcs_phase(const Params& p, LAS unsigned char* lds, int G) {
    LAS float* tab = (LAS float*)lds;
    const int tid = tid_opaque();
    if (tid < 128) { const float a = (float)tid * (1.0f / 64.0f); tab[tid] = cospif(a); tab[128 + tid] = sinpif(a); }
    __syncthreads();
    float* MCS = (float*)(p.ws + OFF_MCS); const float* fw = p.in[8];
    const int total = NL * 4 * 128 * 256;
    for (int e = blockIdx.x * NTHREADS + tid; e < total; e += G * NTHREADS) {
        const int col = e & 255, c = (e >> 8) & 127, lh = e >> 15; const int part = col >> 7, d = col & 127;
        const float* w = fw + (size_t)lh * 128 * 128 + d; float acc = 0.f;
        for (int k = 0; k < 128; ++k) acc += tab[part * 128 + ((c * k) & 127)] * w[(size_t)k * 128];
        MCS[e] = acc;
    }
    __syncthreads();
}

__device__ __forceinline__ void fold_phase(const Params& p, LAS unsigned char* lds, int G) {
    LAS float* Wt = (LAS float*)lds;
    LAS float* Mt = (LAS float*)(lds + 64 * 132 * 4);
    const int tid = tid_opaque();
    const float* MCS = (const float*)(p.ws + OFF_MCS);
    bf16_t* WA = (bf16_t*)(p.ws + OFF_WA); bf16_t* WB = (bf16_t*)(p.ws + OFF_WB);
    const int nitems = NL * 24 * 16;
    for (int it = blockIdx.x; it < nitems; it += G) {
        const int kb = it & 15, ch = (it >> 4) % 24, l = (it >> 4) / 24;
        const float* win = p.in[7] + (size_t)l * 1024 * 1024;
        const float* msrc; int ldm, wcol; bf16_t* dst; const float* scl = nullptr;
        if (ch < 16) { const int h = ch >> 2, cc = ch & 3; msrc = MCS + (size_t)(l * 4 + h) * 128 * 256 + cc * 64; ldm = 256; wcol = h * 128;
            dst = WA + ((size_t)l * 1024 + (cc >> 1) * 512 + h * 128 + (cc & 1) * 64) * 1024; }
        else { const int g = (ch - 16) >> 1, d0 = ((ch - 16) & 1) * 64; msrc = p.in[9] + (size_t)(l * 4 + g) * 128 * 128 + d0; ldm = 128; wcol = 512 + g * 128;
            dst = WB + ((size_t)l * 512 + g * 128 + d0) * 1024; scl = p.in[10] + (size_t)l * 512 + g * 128 + d0; }
#pragma unroll
        for (int i = 0; i < 4; ++i) { const int kk = (tid >> 5) + 16 * i, c4 = (tid & 31) * 4;
            *(LAS f32x4*)(Wt + kk * 132 + c4) = *(const f32x4*)(win + (size_t)(kb * 64 + kk) * 1024 + wcol + c4); }
#pragma unroll
        for (int i = 0; i < 4; ++i) { const int c = (tid >> 4) + 32 * i, j4 = (tid & 15) * 4;
            f32x4 mv = *(const f32x4*)(msrc + (size_t)c * ldm + j4);
            if (scl) mv *= *(const f32x4*)(scl + j4);
            *(LAS f32x4*)(Mt + c * 64 + j4) = mv; }
        __syncthreads();
        const int j = tid & 63, k8 = (tid >> 6) * 8;
        float acc[8];
#pragma unroll
        for (int q = 0; q < 8; ++q) acc[q] = 0.f;
        for (int c4 = 0; c4 < 32; ++c4) {
            const float m0 = Mt[(c4 * 4 + 0) * 64 + j], m1 = Mt[(c4 * 4 + 1) * 64 + j], m2 = Mt[(c4 * 4 + 2) * 64 + j], m3 = Mt[(c4 * 4 + 3) * 64 + j];
#pragma unroll
            for (int q = 0; q < 8; ++q) { const f32x4 w = *(const LAS f32x4*)(Wt + (k8 + q) * 132 + c4 * 4); acc[q] += (w[0] * m0 + w[1] * m1) + (w[2] * m2 + w[3] * m3); }
        }
        u32x4 w; w.x = pg8::cvt_pk_bf16(acc[0], acc[1]); w.y = pg8::cvt_pk_bf16(acc[2], acc[3]); w.z = pg8::cvt_pk_bf16(acc[4], acc[5]); w.w = pg8::cvt_pk_bf16(acc[6], acc[7]);
        *(u32x4*)(dst + (size_t)j * 1024 + kb * 64 + k8) = w;
        __syncthreads();
    }
}

template <int R> __device__ __forceinline__ void pool_group(const LAS unsigned char* tile, int tl, int s, int g, int c16, bf16_t* orow) {
    float a[8];
#pragma unroll
    for (int q = 0; q < 8; ++q) a[q] = 0.f;
    const LAS unsigned char* base = tile + (tl + 8 - R) * 1024 + g * 256 + c16 * 16;
    u32x4 c;
#pragma unroll
    for (int j = 0; j <= 2 * R; ++j) { const u32x4 v = *(const LAS u32x4*)(base + j * 1024); if (j == R) c = v;
        a[0] += bf_lo(v.x); a[1] += bf_hi(v.x); a[2] += bf_lo(v.y); a[3] += bf_hi(v.y); a[4] += bf_lo(v.z); a[5] += bf_hi(v.z); a[6] += bf_lo(v.w); a[7] += bf_hi(v.w); }
    const int lo = (s - R < 0) ? 0 : s - R, hi = (s + R > SEQ - 1) ? SEQ - 1 : s + R;
    const float inv = 1.0f / (float)(hi - lo + 1);
    u32x4 w; w.x = pg8::cvt_pk_bf16(a[0] * inv - bf_lo(c.x), a[1] * inv - bf_hi(c.x)); w.y = pg8::cvt_pk_bf16(a[2] * inv - bf_lo(c.y), a[3] * inv - bf_hi(c.y));
    w.z = pg8::cvt_pk_bf16(a[4] * inv - bf_lo(c.z), a[5] * inv - bf_hi(c.z)); w.w = pg8::cvt_pk_bf16(a[6] * inv - bf_lo(c.w), a[7] * inv - bf_hi(c.w));
    *(u32x4*)(orow + g * 128 + c16 * 8) = w;
}
__device__ __forceinline__ void pool_load(u32x4 (&v)[6], const bf16_t* Q, int ti, int tid) {
    const int b = ti >> 6, s0 = (ti & 63) * 32;
#pragma unroll
    for (int k = 0; k < 6; ++k) { const int id = tid + 512 * k, row = id >> 6, c = id & 63, s = s0 - 8 + row;
        v[k] = (s >= 0 && s < SEQ) ? *(const u32x4*)(Q + ((size_t)(b * SEQ + s)) * 512 + c * 8) : (u32x4){0u, 0u, 0u, 0u}; }
}
__device__ __forceinline__ void pool_phase(const Params& p, LAS unsigned char* lds, int G) {
    const bf16_t* Q = (const bf16_t*)(p.ws + OFF_Q); bf16_t* YC = (bf16_t*)(p.ws + OFF_YCAT);
    const int tid = tid_opaque(), lane = tid & 63, wid = tid >> 6;
    const int ntiles = NTOK / 32;
    u32x4 v[6];
    if ((int)blockIdx.x < ntiles) pool_load(v, Q, blockIdx.x, tid);
    for (int ti = blockIdx.x; ti < ntiles; ti += G) {
#pragma unroll
        for (int k = 0; k < 6; ++k) *(LAS u32x4*)(lds + (size_t)(tid + 512 * k) * 16) = v[k];
        __syncthreads();
        if (ti + G < ntiles) pool_load(v, Q, ti + G, tid);
        const int b = ti >> 6, s0 = (ti & 63) * 32, tl = wid * 4 + (lane >> 4), c16 = lane & 15, s = s0 + tl;
        bf16_t* orow = YC + ((size_t)(b * SEQ + s)) * 1024 + 512;
        pool_group<1>(lds, tl, s, 0, c16, orow); pool_group<2>(lds, tl, s, 1, c16, orow); pool_group<4>(lds, tl, s, 2, c16, orow); pool_group<8>(lds, tl, s, 3, c16, orow);
        __syncthreads();
    }
}

#define XB_TMO      128
#define XB_XCNT(j)  (256  + 64 * (j))
#define XB_XSUB(j)  (1280 + 64 * (j))
#define XB_XGEN(j)  (2304 + 64 * (j))
#define XB_TOP      3328
#define XB_TOPGEN   3392
#define XCD_BAR_WORDS 3456
#define XB_SPIN_CAP (1u << 22)
__device__ __forceinline__ unsigned xb_ld(unsigned* p)              { return __hip_atomic_load(p, __ATOMIC_RELAXED, __HIP_MEMORY_SCOPE_AGENT); }
__device__ __forceinline__ unsigned xb_add(unsigned* p, unsigned v) { return __hip_atomic_fetch_add(p, v, __ATOMIC_RELAXED, __HIP_MEMORY_SCOPE_AGENT); }
__device__ __forceinline__ unsigned xb_xcc_id() { return (unsigned)__builtin_amdgcn_s_getreg((3 << 11) | 20) & 0xFu; }
#define XB_SPIN(cond, bar) do { unsigned _sp = 0; while (cond) { __builtin_amdgcn_s_sleep(1); \
    if ((++_sp & 255u) == 0u) { if (xb_ld(&(bar)[XB_TMO])) break; if (_sp > XB_SPIN_CAP) { atomicAdd(&(bar)[XB_TMO], 1u); break; } } } } while (0)
struct XcdBarrier { unsigned* bar; unsigned x; volatile LAS unsigned* st; };
__device__ __forceinline__ XcdBarrier xcd_barrier_post(unsigned* bar, volatile LAS unsigned* st) {
    XcdBarrier b; b.bar = bar; b.x = xb_xcc_id(); b.st = st;
    if (threadIdx.x == 0) (void)xb_add(&bar[XB_XCNT(b.x)], 1u);
    return b;
}
__device__ __forceinline__ void xcd_barrier_complete(unsigned* bar, unsigned x, unsigned& nloc, unsigned& nx) {
    const unsigned G = gridDim.x * gridDim.y * gridDim.z;
    unsigned sum, cnt, mine, sp = 0u;
    for (;;) {
        sum = 0u; cnt = 0u; mine = 0u;
#pragma unroll
        for (unsigned j = 0; j < 16; ++j) { const unsigned c = xb_ld(&bar[XB_XCNT(j)]); sum += c; cnt += (c > 0u) ? 1u : 0u; mine = (j == x) ? c : mine; }
        if (sum == G) break;
        __builtin_amdgcn_s_sleep(1);
        if ((++sp & 255u) == 0u) { if (xb_ld(&bar[XB_TMO])) break; if (sp > XB_SPIN_CAP) { atomicAdd(&bar[XB_TMO], 1u); break; } }
    }
    nloc = mine > 0u ? mine : 1u; nx = cnt > 0u ? cnt : 1u;
}
__device__ __forceinline__ void xcd_barrier(const XcdBarrier& b) {
    asm volatile("s_waitcnt vmcnt(0)" ::: "memory");
    __syncthreads();
    if (threadIdx.x == 0) {
        unsigned* bar = b.bar;
        __builtin_amdgcn_s_waitcnt(0);
        unsigned nloc = b.st[0], nx = b.st[1];
        if (nloc == 0u) { xcd_barrier_complete(bar, b.x, nloc, nx); b.st[0] = nloc; b.st[1] = nx; }
        const unsigned old = xb_add(&bar[XB_XSUB(b.x)], 1u);
        const unsigned gen = old / nloc;
        if (old + 1u == (gen + 1u) * nloc) {
            __builtin_amdgcn_fence(__ATOMIC_RELEASE, "agent");
            asm volatile("s_waitcnt vmcnt(0)" ::: "memory");
            const unsigned og = xb_add(&bar[XB_TOP], 1u);
            const unsigned tg = og / nx;
            if (og + 1u == (tg + 1u) * nx) xb_add(&bar[XB_TOPGEN], 1u);
            else XB_SPIN(xb_ld(&bar[XB_TOPGEN]) == tg, bar);
            __builtin_amdgcn_fence(__ATOMIC_ACQUIRE, "agent");
            xb_add(&bar[XB_XGEN(b.x)], 1u);
            asm volatile("s_waitcnt vmcnt(0)" ::: "memory");
        } else {
            XB_SPIN(xb_ld(&bar[XB_XGEN(b.x)]) == gen, bar);
            __builtin_amdgcn_fence(__ATOMIC_ACQUIRE, "agent");
            asm volatile("s_waitcnt vmcnt(0)" ::: "memory");
        }
    }
    __syncthreads();
}

constexpr int NPHASES = 2 + NL * 10;
__global__ void __launch_bounds__(NTHREADS, 2) fwd_kernel(Params p) {
    extern __shared__ __attribute__((aligned(16))) unsigned char lds_raw[];
    LAS unsigned char* lds = (LAS unsigned char*)lds_raw;
    cg::grid_group grid = cg::this_grid();
    const int G = gridDim.x;
    volatile LAS unsigned* bst = (volatile LAS unsigned*)(lds + LDS_STAGE);
    if (threadIdx.x == 0) { bst[0] = 0u; bst[1] = 0u; }
    __syncthreads();
    XcdBarrier xbar = xcd_barrier_post((unsigned*)(p.ws + OFF_BAR), bst);
    bf16_t* WGU = (bf16_t*)(p.ws + OFF_WGU); bf16_t* WD = (bf16_t*)(p.ws + OFF_WD); bf16_t* WA = (bf16_t*)(p.ws + OFF_WA); bf16_t* WB = (bf16_t*)(p.ws + OFF_WB);
    bf16_t* WO = (bf16_t*)(p.ws + OFF_WO); bf16_t* TM = (bf16_t*)(p.ws + OFF_TM); bf16_t* H = (bf16_t*)(p.ws + OFF_H); bf16_t* Y = (bf16_t*)(p.ws + OFF_Y);
    bf16_t* HID = (bf16_t*)(p.ws + OFF_HID); bf16_t* PT = (bf16_t*)(p.ws + OFF_PT); bf16_t* Q = (bf16_t*)(p.ws + OFF_Q); bf16_t* YC = (bf16_t*)(p.ws + OFF_YCAT);
    bf16_t* HF = (bf16_t*)(p.ws + OFF_HF); float* NYQ = (float*)(p.ws + OFF_NYQ);

    for (int ph = p.ph_lo; ph < p.ph_hi; ++ph) {
        if (ph > p.ph_lo) { if (ph == p.ph_lo + 1) grid.sync(); else xcd_barrier(xbar); }
        if (ph == 0) {
            for (int rep = 0; rep < PREP_REPS; ++rep) {
            transpose_phase(p, lds, G);
            tm_phase(p, G);
            mcs_phase(p, lds, G);
            }
            norm_phase(nullptr, p.in[0], p.out, H, nullptr, nullptr, p.in[1], 0.f, G);
            continue;
        }
        if (ph == 1) { for (int rep = 0; rep < FOLD_REPS; ++rep) fold_phase(p, lds, G); continue; }
        const int l = (ph - 2) / 10, s = (ph - 2) % 10;
        if (s == 0 || s == 7) {
            const int f = (s == 7);
            pg8::Gemm g{H, WGU + (size_t)(l * 2 + f) * 5632 * 1024, NTOK, 5632, 1024};
            pg8::Order S; S.init(NTOK, 5632, G, (int)blockIdx.x, 0);
            pg8::EpiSwiGLU E{HID, 0};
            for (int rep = 0; rep < GEMM_REPS; ++rep) { E.dry = (rep > 0 && p.ph_lo >= 0); pg8::gemm_phase<pg8::EpiSwiGLU, pg8::Order, true, true>(lds, g, S, E); }
        } else if (s == 2 || s == 6 || s == 9) {
            const float* gpost = (s == 2 ? p.in[5] : s == 6 ? p.in[12] : p.in[17]) + (size_t)l * DM;
            const float* gpre = (s == 2 ? p.in[6] + (size_t)l * DM : s == 6 ? p.in[13] + (size_t)l * DM : p.in[1] + (size_t)(l + 1) * DM);
            const bool fin = (s == 9 && l == NL - 1);
            norm_phase(Y, p.out, p.out, fin ? nullptr : H, s == 2 ? HF : nullptr, gpost, gpre, s == 6 ? 1.0f : 0.5f, G);
        } else {
            const int nsub = (s == 3) ? 2 : 1;
            if (s == 3) nyq_phase(WA + (size_t)l * 1024 * 1024, H, NYQ, G);
            for (int sub = 0; sub < nsub; ++sub) {
                pg8::Gemm g; pg8::Order S; pg8::EpiMap E;
                if (s == 1 || s == 8) { const int f = (s == 8); g = pg8::Gemm{HID, WD + (size_t)(l * 2 + f) * 1024 * 2816, NTOK, 1024, 2816}; S.init(NTOK, 1024, G, (int)blockIdx.x, 0); E = pg8::EpiMap{Y, 1024, 0, 0, nullptr}; }
                else if (s == 3 && sub == 0) { g = pg8::Gemm{WA + (size_t)l * 1024 * 1024, HF, 1024, NTOK, 1024}; S.init(1024, NTOK, G, (int)blockIdx.x, 2); E = pg8::EpiMap{PT, 2048, 1, 0, nullptr}; }
                else if (s == 3) { g = pg8::Gemm{H, WB + (size_t)l * 512 * 1024, NTOK, 512, 1024}; S.init(NTOK, 512, G, (int)blockIdx.x, 0); E = pg8::EpiMap{Q, 512, 0, 0, nullptr}; }
                else if (s == 4) { g = pg8::Gemm{TM, PT, 2048, 8192, 2048}; S.init(2048, 8192, G, (int)blockIdx.x, 1); E = pg8::EpiMap{YC, 1024, 2, 0, NYQ}; }
                else { g = pg8::Gemm{YC, WO + (size_t)l * 1024 * 1024, NTOK, 1024, 1024}; S.init(NTOK, 1024, G, (int)blockIdx.x, 0); E = pg8::EpiMap{Y, 1024, 0, 0, nullptr}; }
                for (int rep = 0; rep < GEMM_REPS; ++rep) { E.dry = (rep > 0 && p.ph_lo >= 0); pg8::gemm_phase<pg8::EpiMap, pg8::Order, true, true>(lds, g, S, E); }
            }
            if (s == 4) for (int rep = 0; rep < POOL_REPS; ++rep) pool_phase(p, lds, G);
        }
    }
}

extern "C" void kernel_launch(void* const* d_in, const int* in_sizes, int n_in, void* d_out, int out_size, void* d_ws, size_t ws_size, hipStream_t stream) {
    static int grid = 0;
    if (grid == 0) {
        if (n_in != 18 || out_size != NTOK * DM || ws_size < WS_END) { fprintf(stderr, "kernel_launch: unexpected shapes (n_in %d out %d ws %zu need %zu)\n", n_in, out_size, ws_size, (size_t)WS_END); grid = -1; return; }
        int dev = 0, cus = 0, per_cu = 0;
        hipGetDevice(&dev); hipDeviceGetAttribute(&cus, hipDeviceAttributeMultiprocessorCount, dev);
        if (hipFuncSetAttribute((const void*)fwd_kernel, hipFuncAttributeMaxDynamicSharedMemorySize, LDS_BYTES) != hipSuccess) { fprintf(stderr, "kernel_launch: hipFuncSetAttribute failed\n"); grid = -1; return; }
        if (hipOccupancyMaxActiveBlocksPerMultiprocessor(&per_cu, (const void*)fwd_kernel, NTHREADS, LDS_BYTES) != hipSuccess || per_cu < 1) { fprintf(stderr, "kernel_launch: occupancy query says %d\n", per_cu); per_cu = 1; }
        (void)hipGetLastError();
        grid = cus * per_cu;
        fprintf(stderr, "kernel_launch: grid %d (cus %d x %d)\n", grid, cus, per_cu);
    }
    if (grid < 0) return;
    if (hipMemsetAsync((char*)d_ws + OFF_BAR, 0, SZ_BAR, stream) != hipSuccess) { fprintf(stderr, "kernel_launch: memset failed\n"); return; }
    Params p{};
    for (int i = 0; i < 18; ++i) p.in[i] = (const float*)d_in[i];
    p.out = (float*)d_out; p.ws = (unsigned char*)d_ws;
#if MULTI_LAUNCH
    for (int ph = 0; ph < NPHASES; ++ph) { p.ph_lo = ph; p.ph_hi = ph + 1; hipLaunchKernelGGL(fwd_kernel, dim3(grid), dim3(NTHREADS), LDS_BYTES, stream, p); }
#else
    p.ph_lo = 0; p.ph_hi = NPHASES;
    void* args[] = {&p};
    hipError_t e = hipLaunchCooperativeKernel((const void*)fwd_kernel, dim3(grid), dim3(NTHREADS), args, LDS_BYTES, stream);
    if (e != hipSuccess) fprintf(stderr, "kernel_launch: cooperative launch failed: %s (grid %d)\n", hipGetErrorString(e), grid);
#endif
}
```

```cpp
#include <hip/hip_runtime.h>
#include <hip/hip_cooperative_groups.h>
#include <cstdio>
#include <cstdint>
namespace cg = cooperative_groups;

#ifndef GEMM_REPS
#define GEMM_REPS 1
#endif
#ifndef NORM_REPS
#define NORM_REPS 1
#endif
#ifndef POOL_REPS
#define POOL_REPS 1
#endif
#ifndef FOLD_REPS
#define FOLD_REPS 1
#endif
#ifndef G1_WGM
#define G1_WGM 4
#endif
#ifndef XCD_LOCAL
#define XCD_LOCAL 1
#endif
#ifndef PREP_REPS
#define PREP_REPS 1
#endif
#ifndef MULTI_LAUNCH
#define MULTI_LAUNCH 0
#endif

#define LAS __attribute__((address_space(3)))
typedef unsigned short bf16_t;
typedef short bf16x8 __attribute__((ext_vector_type(8)));
typedef float f32x4 __attribute__((ext_vector_type(4)));
typedef unsigned u32x4 __attribute__((ext_vector_type(4)));
typedef unsigned u32x2 __attribute__((ext_vector_type(2)));

__device__ __forceinline__ int tid_opaque() { int t; asm volatile("v_mov_b32 %0, %1" : "=v"(t) : "v"(threadIdx.x)); return t; }

constexpr int NTOK = 32768, DM = 1024, FF = 2816, NL = 4, SEQ = 2048, NB = 16;
constexpr float EPS = 1e-6f;
constexpr int NTHREADS = 512;
constexpr int LDS_STAGE = 131072;
constexpr int LDS_BYTES = LDS_STAGE + 16;

constexpr size_t SZ_WGU = (size_t)NL * 2 * 5632 * 1024 * 2;
constexpr size_t SZ_WD = (size_t)NL * 2 * 1024 * 2816 * 2;
constexpr size_t SZ_WA = (size_t)NL * 1024 * 1024 * 2;
constexpr size_t SZ_WB = (size_t)NL * 512 * 1024 * 2;
constexpr size_t SZ_WO = (size_t)NL * 1024 * 1024 * 2;
constexpr size_t SZ_TM = (size_t)2048 * 2048 * 2;
constexpr size_t SZ_MCS = (size_t)NL * 4 * 128 * 256 * 4;
constexpr size_t SZ_H = (size_t)NTOK * 1024 * 2;
constexpr size_t SZ_Y = (size_t)NTOK * 1024 * 2;
constexpr size_t SZ_HID = (size_t)NTOK * 2816 * 2;
constexpr size_t OFF_WGU = 0;
constexpr size_t OFF_WD = OFF_WGU + SZ_WGU;
constexpr size_t OFF_WA = OFF_WD + SZ_WD;
constexpr size_t OFF_WB = OFF_WA + SZ_WA;
constexpr size_t OFF_WO = OFF_WB + SZ_WB;
constexpr size_t OFF_TM = OFF_WO + SZ_WO;
constexpr size_t OFF_MCS = OFF_TM + SZ_TM;
constexpr size_t OFF_H = OFF_MCS + SZ_MCS;
constexpr size_t OFF_Y = OFF_H + SZ_H;
constexpr size_t OFF_HID = OFF_Y + SZ_Y;
constexpr size_t OFF_PT = OFF_HID;
constexpr size_t SZ_PT = (size_t)NB * 512 * 2048 * 2;
constexpr size_t OFF_Q = OFF_PT + SZ_PT;
constexpr size_t SZ_Q = (size_t)NTOK * 512 * 2;
constexpr size_t OFF_YCAT = OFF_Q + SZ_Q;
constexpr size_t SZ_YCAT = (size_t)NTOK * 1024 * 2;
constexpr size_t OFF_HF = OFF_YCAT;
constexpr size_t SZ_HF = (size_t)2 * NB * 1024 * 1024 * 2;
constexpr size_t OFF_BAR = OFF_HID + SZ_HID;
constexpr size_t SZ_BAR = 32768;
constexpr size_t OFF_NYQ = OFF_BAR + SZ_BAR;
constexpr size_t SZ_NYQ = (size_t)NB * 512 * 4;
constexpr size_t WS_END = OFF_NYQ + SZ_NYQ;
static_assert(OFF_YCAT + SZ_YCAT <= OFF_BAR && OFF_HF + SZ_HF <= OFF_BAR, "alias region");

struct Params { const float* in[18]; float* out; unsigned char* ws; int ph_lo, ph_hi; };

namespace pg8 {
constexpr int BM = 256, BK = 64, HALF = 128, HTB = HALF * BK * 2, STAGE_BYTES = 8 * HTB, NXCD = 8, WGM = 8;
__host__ __device__ __forceinline__ int lds_byte(int r, int c) { const int st = (r >> 4) * 2 + (c >> 5), rr = r & 15, cc = c & 31, ob = rr * 64 + cc * 2; return st * 1024 + (ob ^ (((ob >> 9) & 1) << 5)); }
__host__ __device__ __forceinline__ void stage_rc(int b, int& R, int& C) { const int st = b / 1024, sb = b % 1024, swz = sb ^ (((sb >> 9) & 1) << 5); R = (st >> 1) * 16 + swz / 64; C = (st & 1) * 32 + (swz % 64) / 2; }
__host__ __device__ __forceinline__ int perm32(int rho) { const int n = rho >> 4, i = rho & 15; return 8 * (i >> 2) + 4 * n + (i & 3); }

struct Unit { int pm, pn; };
struct Gemm { const bf16_t* A; const bf16_t* Bt; int M, N, K; };

struct Order {
    int nM, nN, nwg, G, c, mode, wgm;
    __device__ void init(int M, int N, int G_, int c_, int mode_, int wgm_ = WGM) { nM = M / BM; nN = N / BM; nwg = (mode_ == 2) ? 256 : nM * nN; G = G_; c = c_; mode = mode_; wgm = wgm_; }
    __device__ bool next(int i, Unit& u) const {
        const long L = (long)i * G + c; if (L >= nwg) return false;
        if (mode == 1) { const int xcd = (int)L & 7, j = (int)L >> 3; const int b = 2 * xcd + (j >> 4); u.pn = b * 2 + ((j >> 3) & 1); u.pm = j & 7; return true; }
        if (mode == 2) { const int x = (int)L & 7, i = (int)L >> 3, part = i >> 4, b = 2 * x + ((i >> 3) & 1); u.pm = part * 2 + (i & 1); u.pn = b * 8 + part * 4 + ((i >> 1) & 3); return true; }
        int wgid = (int)L; { const int q = nwg / NXCD, r = nwg % NXCD, xcd = wgid % NXCD, off = wgid / NXCD; wgid = (xcd < r ? xcd * (q + 1) : r * (q + 1) + (xcd - r) * q) + off; }
        const int nig = wgm * nN, gid = wgid / nig, fm = gid * wgm, gsz = (nM - fm) < wgm ? (nM - fm) : wgm;
        u.pm = fm + ((wgid % nig) % gsz); u.pn = (wgid % nig) / gsz; return true;
    }
    __device__ __forceinline__ void a_ready(const Unit&) const {}
    __device__ __forceinline__ void done(const Unit&) const {}
};

__device__ __forceinline__ unsigned cvt_pk_bf16(float lo, float hi) { unsigned r; asm volatile("v_cvt_pk_bf16_f32 %0, %1, %2" : "=v"(r) : "v"(lo), "v"(hi)); return r; }

struct EpiMap {
    static constexpr bool PERM = true, AFTER_DRAIN = false;
    bf16_t* O; int ldc; int mode; int dry; const float* nyq;
    __device__ __forceinline__ void operator()(const f32x4 (&acc)[2][2][4][2], const Unit& u, int wr, int wc, int fr, int fq) const {
        if (dry) return;
        size_t tb; int ld = ldc;
        if (mode == 0) tb = (size_t)u.pm * 256 * (size_t)ldc + (size_t)u.pn * 256;
        else if (mode == 1) { tb = ((size_t)((u.pn >> 3) * 512 + (u.pm & 1) * 256)) * 2048 + (size_t)((u.pm >> 1) * 1024 + (u.pn & 3) * 256); ld = 2048; }
        else { tb = ((size_t)((u.pn >> 1) * 2048 + u.pm * 256)) * 1024 + (size_t)((u.pn & 1) * 256); ld = 1024; }
        bf16_t* base = O + tb + (size_t)(wr * 64 + fr) * ld + wc * 32 + 8 * fq;
#pragma unroll
        for (int ai = 0; ai < 2; ++ai)
#pragma unroll
            for (int m = 0; m < 4; ++m) { bf16_t* rowp = base + (size_t)(ai * HALF + m * 16) * ld;
#pragma unroll
                for (int bj = 0; bj < 2; ++bj) { f32x4 v0 = acc[ai][bj][m][0], v1 = acc[ai][bj][m][1];
                    if (mode == 2) { const float* q = nyq + (u.pn >> 1) * 512 + (u.pn & 1) * 256 + bj * HALF + wc * 32 + 8 * fq; const float sg = (fr & 1) ? (-1.0f / 512.0f) : (1.0f / 512.0f);
                        v0 += *(const f32x4*)q * sg; v1 += *(const f32x4*)(q + 4) * sg; }
                    u32x4 w; w.x = cvt_pk_bf16(v0[0], v0[1]); w.y = cvt_pk_bf16(v0[2], v0[3]); w.z = cvt_pk_bf16(v1[0], v1[1]); w.w = cvt_pk_bf16(v1[2], v1[3]);
                    *(u32x4*)(rowp + bj * HALF) = w; } }
    }
};
__device__ __forceinline__ float silu_mul(float a, float b) { return a * __builtin_amdgcn_rcpf(1.0f + __expf(-a)) * b; }
struct EpiSwiGLU {
    static constexpr bool PERM = true, AFTER_DRAIN = false;
    bf16_t* O; int dry;
    __device__ __forceinline__ void operator()(const f32x4 (&acc)[2][2][4][2], const Unit& u, int wr, int wc, int fr, int fq) const {
        if (dry) return;
        bf16_t* base = O + (size_t)(u.pm * 256 + wr * 64 + fr) * FF + u.pn * 128 + wc * 32 + 8 * fq;
#pragma unroll
        for (int ai = 0; ai < 2; ++ai)
#pragma unroll
            for (int m = 0; m < 4; ++m) { bf16_t* rowp = base + (size_t)(ai * HALF + m * 16) * FF;
                const f32x4 g0 = acc[ai][0][m][0], g1 = acc[ai][0][m][1], u0 = acc[ai][1][m][0], u1 = acc[ai][1][m][1];
                u32x4 w; w.x = cvt_pk_bf16(silu_mul(g0[0], u0[0]), silu_mul(g0[1], u0[1])); w.y = cvt_pk_bf16(silu_mul(g0[2], u0[2]), silu_mul(g0[3], u0[3]));
                w.z = cvt_pk_bf16(silu_mul(g1[0], u1[0]), silu_mul(g1[1], u1[1])); w.w = cvt_pk_bf16(silu_mul(g1[2], u1[2]), silu_mul(g1[3], u1[3]));
                *(u32x4*)rowp = w; }
    }
};

template <class Epi, class Sched, bool ALIGN_EPI = false, bool SP2 = false>
__device__ __forceinline__ void gemm_phase(LAS unsigned char* lds, const Gemm g, const Sched& S, const Epi& E) {
    const int tid = tid_opaque(), wid = __builtin_amdgcn_readfirstlane(tid >> 6), lane = tid & 63, wr = wid >> 2, wc = wid & 3, fr = lane & 15, fq = lane >> 4;
    const int K = g.K, nt = K / BK;
    unsigned voffA[2], voffB[2];
#pragma unroll
    for (int i = 0; i < 2; ++i) { int R, C; stage_rc(tid * 16 + i * 8192, R, C); const int Rb = Epi::PERM ? ((R & ~31) + perm32(R & 31)) : R;
        voffA[i] = (unsigned)(R * K + C) * 2u; voffB[i] = (unsigned)(Rb * K + C) * 2u; }
    const size_t kstep = (size_t)(BK * 2);
    const size_t hstep = (size_t)HALF * K * 2;
    const size_t tstep = 2 * hstep;
    const unsigned ldsw = (unsigned)wid * 1024u;
    const int aoff = lds_byte(wr * 64 + fr, fq * 8), boff = lds_byte(wc * 32 + fr, fq * 8);
#define PG8_SA(b, h) (((b) * 2 + (h)) * HTB)
#define PG8_SB(b, h) ((4 + (b) * 2 + (h)) * HTB)
#define PG8_STAGE(bufoff, gbase, voff) do { _Pragma("unroll") for (int _i = 0; _i < 2; ++_i) \
        __builtin_amdgcn_global_load_lds((const unsigned*)((const char*)(gbase) + (voff)[_i]), (LAS unsigned*)(lds + (bufoff) + ldsw + _i * 8192), 16, 0, 0); } while (0)
#define PG8_LDA(dst, b, h) do { _Pragma("unroll") for (int m = 0; m < 4; ++m) _Pragma("unroll") for (int k = 0; k < 2; ++k) dst[m][k] = *(const LAS bf16x8*)(lds + PG8_SA(b, h) + aoff + m * 2048 + k * 1024); } while (0)
#define PG8_LDB(dst, b, h) do { _Pragma("unroll") for (int n = 0; n < 2; ++n) _Pragma("unroll") for (int k = 0; k < 2; ++k) dst[n][k] = *(const LAS bf16x8*)(lds + PG8_SB(b, h) + boff + n * 2048 + k * 1024); } while (0)
#define PG8_MMA(ai, bj, At, Bt) do { __builtin_amdgcn_s_setprio(1); _Pragma("unroll") for (int m = 0; m < 4; ++m) _Pragma("unroll") for (int n = 0; n < 2; ++n) _Pragma("unroll") for (int k = 0; k < 2; ++k) \
        acc[ai][bj][m][n] = __builtin_amdgcn_mfma_f32_16x16x32_bf16(Bt[n][k], At[m][k], acc[ai][bj][m][n], 0, 0, 0); __builtin_amdgcn_s_setprio(0); } while (0)
#define PG8_WAIT_V(n) asm volatile("s_waitcnt vmcnt(" #n ")" ::: "memory")
#define PG8_WAIT_L(n) asm volatile("s_waitcnt lgkmcnt(" #n ")" ::: "memory")
#define PG8_BAR __builtin_amdgcn_s_barrier()
#define PG8_SCHED __builtin_amdgcn_sched_barrier(0)
    Unit cur, nxt; int ui = 0;
    if (!S.next(0, cur)) return;
    f32x4 acc[2][2][4][2];
#pragma unroll
    for (int a = 0; a < 2; ++a)
#pragma unroll
        for (int b = 0; b < 2; ++b)
#pragma unroll
            for (int m = 0; m < 4; ++m)
#pragma unroll
                for (int n = 0; n < 2; ++n) acc[a][b][m][n] = (f32x4){0.f, 0.f, 0.f, 0.f};
    bf16x8 At[4][2], B0[2][2], B1[2][2];
    const char* cA = (const char*)g.A + (size_t)cur.pm * tstep; const char* cB = (const char*)g.Bt + (size_t)cur.pn * tstep;
    S.a_ready(cur);
    if constexpr (SP2) {
        PG8_STAGE(PG8_SB(0, 0), cB, voffB); PG8_STAGE(PG8_SB(0, 1), cB + hstep, voffB); PG8_STAGE(PG8_SA(0, 0), cA, voffA); PG8_STAGE(PG8_SA(0, 1), cA + hstep, voffA);
        if (wr == 1) PG8_BAR;
        PG8_WAIT_V(2); PG8_BAR;
        PG8_STAGE(PG8_SB(1, 0), cB + kstep, voffB); PG8_STAGE(PG8_SA(1, 0), cA + kstep, voffA); PG8_STAGE(PG8_SB(1, 1), cB + hstep + kstep, voffB);
        PG8_WAIT_V(6); PG8_BAR;
    } else {
        PG8_STAGE(PG8_SB(0, 0), cB, voffB); PG8_STAGE(PG8_SA(0, 0), cA, voffA); PG8_STAGE(PG8_SB(0, 1), cB + hstep, voffB); PG8_STAGE(PG8_SA(0, 1), cA + hstep, voffA);
        if (wr == 1) PG8_BAR;
        PG8_WAIT_V(4); PG8_BAR;
        PG8_STAGE(PG8_SB(1, 0), cB + kstep, voffB); PG8_STAGE(PG8_SA(1, 0), cA + kstep, voffA); PG8_STAGE(PG8_SB(1, 1), cB + hstep + kstep, voffB);
        PG8_WAIT_V(6); PG8_BAR;
    }
    for (;;) {
        const bool has_next = S.next(ui + 1, nxt);
        const char* nA = has_next ? (const char*)g.A + (size_t)nxt.pm * tstep : cA; const char* nB = has_next ? (const char*)g.Bt + (size_t)nxt.pn * tstep : cB;
        for (int t = 0; t < nt; t += 2) {
            const bool last = (t == nt - 2);
            const char* a1 = cA + (size_t)(t + 1) * kstep;
            const char* a2 = last ? nA : cA + (size_t)(t + 2) * kstep; const char* b2 = last ? nB : cB + (size_t)(t + 2) * kstep;
            const char* a3 = a2 + kstep; const char* b3 = b2 + kstep;
            if (last && has_next) S.a_ready(nxt);
            if constexpr (SP2) {
            PG8_LDB(B0, 0, 0); PG8_LDB(B1, 0, 1); PG8_SCHED; PG8_LDA(At, 0, 0); PG8_STAGE(PG8_SA(1, 1), a1 + hstep, voffA);
            PG8_WAIT_V(8); PG8_WAIT_L(0); PG8_BAR; PG8_MMA(0, 0, At, B0); PG8_MMA(0, 1, At, B1); PG8_BAR; PG8_SCHED;
            PG8_LDA(At, 0, 1); PG8_STAGE(PG8_SB(0, 0), b2, voffB); PG8_STAGE(PG8_SB(0, 1), b2 + hstep, voffB); PG8_STAGE(PG8_SA(0, 0), a2, voffA);
            PG8_WAIT_V(8); PG8_WAIT_L(0); PG8_BAR; PG8_MMA(1, 0, At, B0); PG8_MMA(1, 1, At, B1); PG8_BAR; PG8_SCHED;
            PG8_LDB(B0, 1, 0); PG8_LDB(B1, 1, 1); PG8_SCHED; PG8_LDA(At, 1, 0); PG8_STAGE(PG8_SA(0, 1), a2 + hstep, voffA);
            PG8_WAIT_V(8); PG8_WAIT_L(0); PG8_BAR; PG8_MMA(0, 0, At, B0); PG8_MMA(0, 1, At, B1); PG8_BAR; PG8_SCHED;
            PG8_LDA(At, 1, 1); PG8_STAGE(PG8_SB(1, 0), b3, voffB); PG8_STAGE(PG8_SB(1, 1), b3 + hstep, voffB); PG8_STAGE(PG8_SA(1, 0), a3, voffA);
            PG8_WAIT_V(8); PG8_WAIT_L(0); PG8_BAR; PG8_MMA(1, 0, At, B0); PG8_MMA(1, 1, At, B1); PG8_BAR; PG8_SCHED;
            } else {
            PG8_LDB(B0, 0, 0); PG8_SCHED; PG8_LDA(At, 0, 0); PG8_STAGE(PG8_SA(1, 1), a1 + hstep, voffA);
            PG8_WAIT_L(8); PG8_BAR; PG8_WAIT_L(0); PG8_MMA(0, 0, At, B0); PG8_BAR; PG8_SCHED;
            PG8_LDB(B1, 0, 1); PG8_STAGE(PG8_SB(0, 0), b2, voffB);
            PG8_BAR; PG8_WAIT_L(0); PG8_MMA(0, 1, At, B1); PG8_BAR;
            PG8_LDA(At, 0, 1); PG8_STAGE(PG8_SA(0, 0), a2, voffA);
            PG8_BAR; PG8_WAIT_L(0); PG8_MMA(1, 0, At, B0); PG8_BAR; PG8_SCHED;
            PG8_STAGE(PG8_SB(0, 1), b2 + hstep, voffB);
            PG8_WAIT_V(6); PG8_BAR; PG8_MMA(1, 1, At, B1); PG8_BAR;
            PG8_LDB(B0, 1, 0); PG8_SCHED; PG8_LDA(At, 1, 0); PG8_STAGE(PG8_SA(0, 1), a2 + hstep, voffA);
            PG8_WAIT_L(8); PG8_BAR; PG8_WAIT_L(0); PG8_MMA(0, 0, At, B0); PG8_BAR; PG8_SCHED;
            PG8_LDB(B1, 1, 1); PG8_STAGE(PG8_SB(1, 0), b3, voffB);
            PG8_BAR; PG8_WAIT_L(0); PG8_MMA(0, 1, At, B1); PG8_BAR;
            PG8_LDA(At, 1, 1); PG8_STAGE(PG8_SA(1, 0), a3, voffA);
            PG8_BAR; PG8_WAIT_L(0); PG8_MMA(1, 0, At, B0); PG8_BAR; PG8_SCHED;
            PG8_STAGE(PG8_SB(1, 1), b3 + hstep, voffB);
            PG8_WAIT_V(6); PG8_BAR; PG8_MMA(1, 1, At, B1); PG8_BAR;
            }
        }
        if constexpr (ALIGN_EPI) { if (wr == 0) PG8_BAR; }
        if constexpr (!Epi::AFTER_DRAIN) { E(acc, cur, wr, wc, fr, fq); S.done(cur); }
        if (!has_next) break;
#pragma unroll
        for (int a = 0; a < 2; ++a)
#pragma unroll
            for (int b = 0; b < 2; ++b)
#pragma unroll
                for (int m = 0; m < 4; ++m)
#pragma unroll
                    for (int n = 0; n < 2; ++n) acc[a][b][m][n] = (f32x4){0.f, 0.f, 0.f, 0.f};
        cur = nxt; cA = nA; cB = nB; ++ui;
        if constexpr (ALIGN_EPI) { if (wr == 1) PG8_BAR; }
    }
    PG8_WAIT_V(0);
    if constexpr (!ALIGN_EPI) { if (wr == 0) PG8_BAR; }
    PG8_BAR;
#undef PG8_SA
#undef PG8_SB
#undef PG8_STAGE
#undef PG8_LDA
#undef PG8_LDB
#undef PG8_MMA
#undef PG8_WAIT_V
#undef PG8_WAIT_L
#undef PG8_BAR
#undef PG8_SCHED
}
}

__device__ __forceinline__ float wave_sum(float v) {
    v += __shfl_xor(v, 32); v += __shfl_xor(v, 16); v += __shfl_xor(v, 8); v += __shfl_xor(v, 4); v += __shfl_xor(v, 2); v += __shfl_xor(v, 1); return v;
}
__device__ __forceinline__ float bf_lo(unsigned u) { return __uint_as_float(u << 16); }
__device__ __forceinline__ float bf_hi(unsigned u) { return __uint_as_float(u & 0xffff0000u); }

struct NormRows { f32x4 x0[4], x1[4]; u32x2 y0[4], y1[4]; };
__device__ __forceinline__ void norm_rows_of(int qq, int& bk, int& r0, int& r1) {
    const int x = (qq >> 3) & 7, pl = ((qq >> 6) << 3) | (qq & 7), b = 2 * x + (pl >> 10), k = pl & 1023;
    bk = b * 1024 + k; r0 = b * SEQ + k; r1 = b * SEQ + (k == 0 ? SEQ / 2 : SEQ - k);
}
__device__ __forceinline__ void norm_load(NormRows& r, const bf16_t* y, const float* xin, int r0, int r1, int lane, bool has_y) {
    const size_t o0 = (size_t)r0 * DM + lane * 4, o1 = (size_t)r1 * DM + lane * 4;
#pragma unroll
    for (int j = 0; j < 4; ++j) { r.x0[j] = __builtin_nontemporal_load((const f32x4*)(xin + o0 + 256 * j)); r.x1[j] = __builtin_nontemporal_load((const f32x4*)(xin + o1 + 256 * j)); }
    if (has_y) {
#pragma unroll
        for (int j = 0; j < 4; ++j) { r.y0[j] = __builtin_nontemporal_load((const u32x2*)(y + o0 + 256 * j)); r.y1[j] = __builtin_nontemporal_load((const u32x2*)(y + o1 + 256 * j)); }
    }
}
__device__ __forceinline__ void norm_phase(const bf16_t* y, const float* xin, float* xout, bf16_t* h, bf16_t* hf, const float* gpost, const float* gpre, float coef, int G, int c) {
    const int tid = tid_opaque(); const int lane = tid & 63, wid = tid >> 6;
    const int gw = c * 8 + wid, nw = G * 8;
    const bool has_y = (y != nullptr), has_h = (h != nullptr), fold = (hf != nullptr);
    f32x4 gp[4], gq[4];
#pragma unroll
    for (int j = 0; j < 4; ++j) {
        gp[j] = has_y ? *(const f32x4*)(gpost + lane * 4 + 256 * j) : (f32x4){0.f, 0.f, 0.f, 0.f};
        gq[j] = has_h ? *(const f32x4*)(gpre + lane * 4 + 256 * j) : (f32x4){0.f, 0.f, 0.f, 0.f};
    }
    NormRows cur, nxt;
    int r0, r1, bk;
    if (gw < NTOK / 2) { norm_rows_of(gw, bk, r0, r1); norm_load(cur, y, xin, r0, r1, lane, has_y); }
    for (int q = gw; q < NTOK / 2; q += nw) {
        norm_rows_of(q, bk, r0, r1);
        if (q + nw < NTOK / 2) { int n0, n1, nb; norm_rows_of(q + nw, nb, n0, n1); norm_load(nxt, y, xin, n0, n1, lane, has_y); }
        const size_t o0 = (size_t)r0 * DM + lane * 4, o1 = (size_t)r1 * DM + lane * 4;
        f32x4 x0[4], x1[4];
#pragma unroll
        for (int j = 0; j < 4; ++j) { x0[j] = cur.x0[j]; x1[j] = cur.x1[j]; }
        if (has_y) {
            f32x4 v0[4], v1[4]; float s0 = 0.f, s1 = 0.f;
#pragma unroll
            for (int j = 0; j < 4; ++j) {
                v0[j] = (f32x4){bf_lo(cur.y0[j].x), bf_hi(cur.y0[j].x), bf_lo(cur.y0[j].y), bf_hi(cur.y0[j].y)};
                v1[j] = (f32x4){bf_lo(cur.y1[j].x), bf_hi(cur.y1[j].x), bf_lo(cur.y1[j].y), bf_hi(cur.y1[j].y)};
                s0 += (v0[j][0] * v0[j][0] + v0[j][1] * v0[j][1]) + (v0[j][2] * v0[j][2] + v0[j][3] * v0[j][3]);
                s1 += (v1[j][0] * v1[j][0] + v1[j][1] * v1[j][1]) + (v1[j][2] * v1[j][2] + v1[j][3] * v1[j][3]);
            }
            s0 = wave_sum(s0); s1 = wave_sum(s1);
            const float c0 = coef * rsqrtf(s0 * (1.0f / DM) + EPS), c1 = coef * rsqrtf(s1 * (1.0f / DM) + EPS);
#pragma unroll
            for (int j = 0; j < 4; ++j) { x0[j] += v0[j] * gp[j] * c0; x1[j] += v1[j] * gp[j] * c1; }
        }
#pragma unroll
        for (int j = 0; j < 4; ++j) { *(f32x4*)(xout + o0 + 256 * j) = x0[j]; *(f32x4*)(xout + o1 + 256 * j) = x1[j]; }
        if (has_h) {
            float s0 = 0.f, s1 = 0.f;
#pragma unroll
            for (int j = 0; j < 4; ++j) {
                s0 += (x0[j][0] * x0[j][0] + x0[j][1] * x0[j][1]) + (x0[j][2] * x0[j][2] + x0[j][3] * x0[j][3]);
                s1 += (x1[j][0] * x1[j][0] + x1[j][1] * x1[j][1]) + (x1[j][2] * x1[j][2] + x1[j][3] * x1[j][3]);
            }
            s0 = wave_sum(s0); s1 = wave_sum(s1);
            const float c0 = rsqrtf(s0 * (1.0f / DM) + EPS), c1 = rsqrtf(s1 * (1.0f / DM) + EPS);
            const float fs = ((bk & 1023) == 0) ? 0.f : 1.f;
            const size_t oe = ((size_t)(bk >> 10) * 2048 + (bk & 1023)) * DM + lane * 4, oo = oe + (size_t)1024 * DM;
#pragma unroll
            for (int j = 0; j < 4; ++j) {
                const f32x4 a = x0[j] * gq[j] * c0, b = x1[j] * gq[j] * c1;
                u32x2 wa, wb; wa.x = pg8::cvt_pk_bf16(a[0], a[1]); wa.y = pg8::cvt_pk_bf16(a[2], a[3]); wb.x = pg8::cvt_pk_bf16(b[0], b[1]); wb.y = pg8::cvt_pk_bf16(b[2], b[3]);
                *(u32x2*)(h + o0 + 256 * j) = wa; *(u32x2*)(h + o1 + 256 * j) = wb;
                if (fold) { const f32x4 e = a + b * fs, o = (a - b) * fs;
                    u32x2 we, wo; we.x = pg8::cvt_pk_bf16(e[0], e[1]); we.y = pg8::cvt_pk_bf16(e[2], e[3]); wo.x = pg8::cvt_pk_bf16(o[0], o[1]); wo.y = pg8::cvt_pk_bf16(o[2], o[3]);
                    *(u32x2*)(hf + oe + 256 * j) = we; *(u32x2*)(hf + oo + 256 * j) = wo; }
            }
        }
        cur = nxt;
    }
}

struct TrJob { const float* src; bf16_t* dst; int N, tn, ldd, kind, t0; };
__device__ __forceinline__ TrJob tr_decode(const Params& p, int R) {
    constexpr int TPL = 4480;
    bf16_t* WGU = (bf16_t*)(p.ws + OFF_WGU); bf16_t* WD = (bf16_t*)(p.ws + OFF_WD); bf16_t* WO = (bf16_t*)(p.ws + OFF_WO);
    const int ti0 = R * 4, l = ti0 / TPL, r = ti0 % TPL; int m = r / 704; if (m > 6) m = 6;
    TrJob j; j.t0 = r - m * 704;
    if (m == 0) { j.src = p.in[2] + (size_t)l * 1024 * 2816; j.N = 2816; j.tn = 44; j.dst = WGU + (size_t)(l * 2 + 0) * 5632 * 1024; j.ldd = 1024; j.kind = 0; }
    else if (m == 1) { j.src = p.in[3] + (size_t)l * 1024 * 2816; j.N = 2816; j.tn = 44; j.dst = WGU + (size_t)(l * 2 + 0) * 5632 * 1024; j.ldd = 1024; j.kind = 1; }
    else if (m == 2) { j.src = p.in[4] + (size_t)l * 2816 * 1024; j.N = 1024; j.tn = 16; j.dst = WD + (size_t)(l * 2 + 0) * 1024 * 2816; j.ldd = 2816; j.kind = 2; }
    else if (m == 3) { j.src = p.in[14] + (size_t)l * 1024 * 2816; j.N = 2816; j.tn = 44; j.dst = WGU + (size_t)(l * 2 + 1) * 5632 * 1024; j.ldd = 1024; j.kind = 0; }
    else if (m == 4) { j.src = p.in[15] + (size_t)l * 1024 * 2816; j.N = 2816; j.tn = 44; j.dst = WGU + (size_t)(l * 2 + 1) * 5632 * 1024; j.ldd = 1024; j.kind = 1; }
    else if (m == 5) { j.src = p.in[16] + (size_t)l * 2816 * 1024; j.N = 1024; j.tn = 16; j.dst = WD + (size_t)(l * 2 + 1) * 1024 * 2816; j.ldd = 2816; j.kind = 2; }
    else { j.src = p.in[11] + (size_t)l * 1024 * 1024; j.N = 1024; j.tn = 16; j.dst = WO + (size_t)l * 1024 * 1024; j.ldd = 1024; j.kind = 2; }
    return j;
}
__device__ __forceinline__ void tr_load(f32x4 (&v)[4][2], const TrJob& j, int tid) {
#pragma unroll
    for (int q = 0; q < 4; ++q) { const int t = j.t0 + q, kt = t / j.tn, ntile = t - kt * j.tn;
#pragma unroll
        for (int i = 0; i < 2; ++i) v[q][i] = __builtin_nontemporal_load((const f32x4*)(j.src + (size_t)(kt * 64 + (tid >> 4) + 32 * i) * j.N + ntile * 64 + (tid & 15) * 4)); }
}
__device__ __forceinline__ void transpose_phase(const Params& p, LAS unsigned char* lds, int G) {
    LAS float* T = (LAS float*)lds;
    const int tid = tid_opaque();
    const int nrounds = NL * 4480 / 4;
    f32x4 v[4][2];
    TrJob cur, nxt;
    if ((int)blockIdx.x < nrounds) { cur = tr_decode(p, blockIdx.x); tr_load(v, cur, tid); }
    for (int R = blockIdx.x; R < nrounds; R += G) {
#pragma unroll
        for (int q = 0; q < 4; ++q)
#pragma unroll
            for (int i = 0; i < 2; ++i) { LAS float* d = T + q * 4160 + ((tid >> 4) + 32 * i) * 65 + (tid & 15) * 4; d[0] = v[q][i][0]; d[1] = v[q][i][1]; d[2] = v[q][i][2]; d[3] = v[q][i][3]; }
        __syncthreads();
        nxt = cur;
        if (R + G < nrounds) { nxt = tr_decode(p, R + G); tr_load(v, nxt, tid); }
#pragma unroll
        for (int q = 0; q < 4; ++q) { const int t = cur.t0 + q, kt = t / cur.tn, ntile = t - kt * cur.tn;
            const int nl = tid >> 3, k8 = (tid & 7) * 8; const int n = ntile * 64 + nl;
            const int drow = (cur.kind == 2) ? n : ((n >> 7) * 256 + (n & 127) + (cur.kind == 1 ? 128 : 0));
            const LAS float* s = T + q * 4160 + k8 * 65 + nl;
            u32x4 w; w.x = pg8::cvt_pk_bf16(s[0], s[65]); w.y = pg8::cvt_pk_bf16(s[130], s[195]); w.z = pg8::cvt_pk_bf16(s[260], s[325]); w.w = pg8::cvt_pk_bf16(s[390], s[455]);
            *(u32x4*)(cur.dst + (size_t)drow * cur.ldd + kt * 64 + k8) = w; }
        __syncthreads();
        cur = nxt;
    }
}

__device__ __forceinline__ void tm_phase(const Params& p, int G) {
    bf16_t* TM = (bf16_t*)(p.ws + OFF_TM);
    const int total = 2048 * 2048 / 8; const int tid = tid_opaque();
    for (int e = blockIdx.x * NTHREADS + tid; e < total; e += G * NTHREADS) {
        const int s = e >> 8, k0 = (e & 255) * 8; float v[8];
#pragma unroll
        for (int j = 0; j < 8; ++j) { const int k = k0 + j, kk = k & 1023; const int ph = (s * kk) & 2047; const float a = (float)ph * (1.0f / 1024.0f);
            v[j] = (k < 1024) ? cospif(a) * (1.0f / 512.0f) : -sinpif(a) * (1.0f / 512.0f); }
        u32x4 w; w.x = pg8::cvt_pk_bf16(v[0], v[1]); w.y = pg8::cvt_pk_bf16(v[2], v[3]); w.z = pg8::cvt_pk_bf16(v[4], v[5]); w.w = pg8::cvt_pk_bf16(v[6], v[7]);
        *(u32x4*)(TM + (size_t)e * 8) = w;
    }
}

__device__ __forceinline__ void nyq_phase(const bf16_t* WA, const bf16_t* H, float* nyq, int G, int c) {
    const int tid = tid_opaque(), lane = tid & 63, wid = tid >> 6;
    for (int tt = c * 8 + wid; tt < NB * 512; tt += G * 8) {
        const int x = (tt >> 3) & 7, tl = ((tt >> 6) << 3) | (tt & 7), b = 2 * x + (tl >> 9), n = tl & 511, t = b * 512 + n;
        const bf16_t* w = WA + (size_t)n * 1024 + lane * 8; const bf16_t* h = H + ((size_t)b * SEQ + 1024) * 1024 + lane * 8;
        float acc = 0.f;
#pragma unroll
        for (int j = 0; j < 2; ++j) { const u32x4 a = *(const u32x4*)(w + 512 * j), c = *(const u32x4*)(h + 512 * j);
            acc += bf_lo(a.x) * bf_lo(c.x) + bf_hi(a.x) * bf_hi(c.x) + bf_lo(a.y) * bf_lo(c.y) + bf_hi(a.y) * bf_hi(c.y) + bf_lo(a.z) * bf_lo(c.z) + bf_hi(a.z) * bf_hi(c.z) + bf_lo(a.w) * bf_lo(c.w) + bf_hi(a.w) * bf_hi(c.w); }
        acc = wave_sum(acc);
        if (lane == 0) nyq[t] = acc;
    }
}

__device__ __forceinline__ void mcs_phase(const Params& p, LAS unsigned char* lds, int G) {
    LAS float* tab = (LAS float*)lds;
    const int tid = tid_opaque();
    if (tid < 128) { const float a = (float)tid * (1.0f / 64.0f); tab[tid] = cospif(a); tab[128 + tid] = sinpif(a); }
    __syncthreads();
    float* MCS = (float*)(p.ws + OFF_MCS); const float* fw = p.in[8];
    const int total = NL * 4 * 128 * 256;
    for (int e = blockIdx.x * NTHREADS + tid; e < total; e += G * NTHREADS) {
        const int col = e & 255, c = (e >> 8) & 127, lh = e >> 15; const int part = col >> 7, d = col & 127;
        const float* w = fw + (size_t)lh * 128 * 128 + d; float acc = 0.f;
        for (int k = 0; k < 128; ++k) acc += tab[part * 128 + ((c * k) & 127)] * w[(size_t)k * 128];
        MCS[e] = acc;
    }
    __syncthreads();
}

__device__ __forceinline__ void fold_phase(const Params& p, LAS unsigned char* lds, int G) {
    LAS float* Wt = (LAS float*)lds;
    LAS float* Mt = (LAS float*)(lds + 128 * 132 * 4);
    const int tid = tid_opaque();
    const float* MCS = (const float*)(p.ws + OFF_MCS);
    bf16_t* WA = (bf16_t*)(p.ws + OFF_WA); bf16_t* WB = (bf16_t*)(p.ws + OFF_WB);
    const int nitems = NL * 24 * 8;
    for (int it = blockIdx.x; it < nitems; it += G) {
        const int kb = it & 7, ch = (it >> 3) % 24, l = (it >> 3) / 24;
        const float* win = p.in[7] + (size_t)l * 1024 * 1024;
        const float* msrc; int ldm, wcol; bf16_t* dst; const float* scl = nullptr;
        if (ch < 16) { const int h = ch >> 2, cc = ch & 3; msrc = MCS + (size_t)(l * 4 + h) * 128 * 256 + cc * 64; ldm = 256; wcol = h * 128;
            dst = WA + ((size_t)l * 1024 + (cc >> 1) * 512 + h * 128 + (cc & 1) * 64) * 1024; }
        else { const int g = (ch - 16) >> 1, d0 = ((ch - 16) & 1) * 64; msrc = p.in[9] + (size_t)(l * 4 + g) * 128 * 128 + d0; ldm = 128; wcol = 512 + g * 128;
            dst = WB + ((size_t)l * 512 + g * 128 + d0) * 1024; scl = p.in[10] + (size_t)l * 512 + g * 128 + d0; }
#pragma unroll
        for (int i = 0; i < 8; ++i) { const int kk = (tid >> 5) + 16 * i, c4 = (tid & 31) * 4;
            *(LAS f32x4*)(Wt + kk * 132 + c4) = *(const f32x4*)(win + (size_t)(kb * 128 + kk) * 1024 + wcol + c4); }
#pragma unroll
        for (int i = 0; i < 4; ++i) { const int c = (tid >> 4) + 32 * i, j4 = (tid & 15) * 4;
            f32x4 mv = *(const f32x4*)(msrc + (size_t)c * ldm + j4);
            if (scl) mv *= *(const f32x4*)(scl + j4);
            *(LAS f32x4*)(Mt + c * 64 + j4) = mv; }
        __syncthreads();
        const int j4 = (tid & 15) * 4, k4 = (tid >> 4) * 4;
        f32x4 acc[4];
#pragma unroll
        for (int q = 0; q < 4; ++q) acc[q] = (f32x4){0.f, 0.f, 0.f, 0.f};
        for (int c4 = 0; c4 < 32; ++c4) {
            const f32x4 m0 = *(const LAS f32x4*)(Mt + (c4 * 4 + 0) * 64 + j4), m1 = *(const LAS f32x4*)(Mt + (c4 * 4 + 1) * 64 + j4);
            const f32x4 m2 = *(const LAS f32x4*)(Mt + (c4 * 4 + 2) * 64 + j4), m3 = *(const LAS f32x4*)(Mt + (c4 * 4 + 3) * 64 + j4);
#pragma unroll
            for (int q = 0; q < 4; ++q) { const f32x4 w = *(const LAS f32x4*)(Wt + (k4 + q) * 132 + c4 * 4); acc[q] += (m0 * w[0] + m1 * w[1]) + (m2 * w[2] + m3 * w[3]); }
        }
#pragma unroll
        for (int jj = 0; jj < 4; ++jj) { u32x2 w; w.x = pg8::cvt_pk_bf16(acc[0][jj], acc[1][jj]); w.y = pg8::cvt_pk_bf16(acc[2][jj], acc[3][jj]);
            *(u32x2*)(dst + (size_t)(j4 + jj) * 1024 + kb * 128 + k4) = w; }
        __syncthreads();
    }
}

template <int R> __device__ __forceinline__ void pool_group(const LAS unsigned char* tile, int tl, int s, int g, int c16, bf16_t* orow) {
    float a[8];
#pragma unroll
    for (int q = 0; q < 8; ++q) a[q] = 0.f;
    const LAS unsigned char* base = tile + (tl + 8 - R) * 1024 + g * 256 + c16 * 16;
    u32x4 c;
#pragma unroll
    for (int j = 0; j <= 2 * R; ++j) { const u32x4 v = *(const LAS u32x4*)(base + j * 1024); if (j == R) c = v;
        a[0] += bf_lo(v.x); a[1] += bf_hi(v.x); a[2] += bf_lo(v.y); a[3] += bf_hi(v.y); a[4] += bf_lo(v.z); a[5] += bf_hi(v.z); a[6] += bf_lo(v.w); a[7] += bf_hi(v.w); }
    const int lo = (s - R < 0) ? 0 : s - R, hi = (s + R > SEQ - 1) ? SEQ - 1 : s + R;
    const float inv = 1.0f / (float)(hi - lo + 1);
    u32x4 w; w.x = pg8::cvt_pk_bf16(a[0] * inv - bf_lo(c.x), a[1] * inv - bf_hi(c.x)); w.y = pg8::cvt_pk_bf16(a[2] * inv - bf_lo(c.y), a[3] * inv - bf_hi(c.y));
    w.z = pg8::cvt_pk_bf16(a[4] * inv - bf_lo(c.z), a[5] * inv - bf_hi(c.z)); w.w = pg8::cvt_pk_bf16(a[6] * inv - bf_lo(c.w), a[7] * inv - bf_hi(c.w));
    *(u32x4*)(orow + g * 128 + c16 * 8) = w;
}
__device__ __forceinline__ void pool_load(u32x4 (&v)[6], const bf16_t* Q, int ti, int tid) {
    const int b = ti >> 6, s0 = (ti & 63) * 32;
#pragma unroll
    for (int k = 0; k < 6; ++k) { const int id = tid + 512 * k, row = id >> 6, c = id & 63, s = s0 - 8 + row;
        v[k] = (s >= 0 && s < SEQ) ? *(const u32x4*)(Q + ((size_t)(b * SEQ + s)) * 512 + c * 8) : (u32x4){0u, 0u, 0u, 0u}; }
}
__device__ __forceinline__ int pool_tile_of(int tt) { return (tt & 7) * 128 + (tt >> 3); }
__device__ __forceinline__ void pool_phase(const bf16_t* Q, bf16_t* YC, LAS unsigned char* lds, int G, int c) {
    const int tid = tid_opaque(), lane = tid & 63, wid = tid >> 6;
    const int ntiles = NTOK / 32;
    u32x4 v[6];
    if (c < ntiles) pool_load(v, Q, pool_tile_of(c), tid);
    for (int tt = c; tt < ntiles; tt += G) {
        const int ti = pool_tile_of(tt);
#pragma unroll
        for (int k = 0; k < 6; ++k) *(LAS u32x4*)(lds + (size_t)(tid + 512 * k) * 16) = v[k];
        __syncthreads();
        if (tt + G < ntiles) pool_load(v, Q, pool_tile_of(tt + G), tid);
        const int b = ti >> 6, s0 = (ti & 63) * 32, tl = wid * 4 + (lane >> 4), c16 = lane & 15, s = s0 + tl;
        bf16_t* orow = YC + ((size_t)(b * SEQ + s)) * 1024 + 512;
        pool_group<1>(lds, tl, s, 0, c16, orow); pool_group<2>(lds, tl, s, 1, c16, orow); pool_group<4>(lds, tl, s, 2, c16, orow); pool_group<8>(lds, tl, s, 3, c16, orow);
        __syncthreads();
    }
}

#define XB_TMO      128
#define XB_XCNT(j)  (256  + 64 * (j))
#define XB_XSUB(j)  (1280 + 64 * (j))
#define XB_XGEN(j)  (2304 + 64 * (j))
#define XB_TOP      3328
#define XB_TOPGEN   3392
#define XCD_BAR_WORDS 3456
#define XB_SPIN_CAP (1u << 22)
__device__ __forceinline__ unsigned xb_ld(unsigned* p)              { return __hip_atomic_load(p, __ATOMIC_RELAXED, __HIP_MEMORY_SCOPE_AGENT); }
__device__ __forceinline__ unsigned xb_add(unsigned* p, unsigned v) { return __hip_atomic_fetch_add(p, v, __ATOMIC_RELAXED, __HIP_MEMORY_SCOPE_AGENT); }
__device__ __forceinline__ unsigned xb_xcc_id() { return (unsigned)__builtin_amdgcn_s_getreg((3 << 11) | 20) & 0xFu; }
#define XB_SPIN(cond, bar) do { unsigned _sp = 0; while (cond) { __builtin_amdgcn_s_sleep(1); \
    if ((++_sp & 255u) == 0u) { if (xb_ld(&(bar)[XB_TMO])) break; if (_sp > XB_SPIN_CAP) { atomicAdd(&(bar)[XB_TMO], 1u); break; } } } } while (0)
struct XcdBarrier { unsigned* bar; unsigned x; volatile LAS unsigned* st; };
__device__ __forceinline__ XcdBarrier xcd_barrier_post(unsigned* bar, volatile LAS unsigned* st) {
    XcdBarrier b; b.bar = bar; b.x = xb_xcc_id(); b.st = st;
    if (threadIdx.x == 0) (void)xb_add(&bar[XB_XCNT(b.x)], 1u);
    return b;
}
__device__ __forceinline__ void xcd_barrier_complete(unsigned* bar, unsigned x, unsigned& nloc, unsigned& nx) {
    const unsigned G = gridDim.x * gridDim.y * gridDim.z;
    unsigned sum, cnt, mine, sp = 0u;
    for (;;) {
        sum = 0u; cnt = 0u; mine = 0u;
#pragma unroll
        for (unsigned j = 0; j < 16; ++j) { const unsigned c = xb_ld(&bar[XB_XCNT(j)]); sum += c; cnt += (c > 0u) ? 1u : 0u; mine = (j == x) ? c : mine; }
        if (sum == G) break;
        __builtin_amdgcn_s_sleep(1);
        if ((++sp & 255u) == 0u) { if (xb_ld(&bar[XB_TMO])) break; if (sp > XB_SPIN_CAP) { atomicAdd(&bar[XB_TMO], 1u); break; } }
    }
    nloc = mine > 0u ? mine : 1u; nx = cnt > 0u ? cnt : 1u;
}
__device__ __forceinline__ unsigned xcd_census_uniform(unsigned* bar) {
    if (gridDim.x != 256u) return 0u;
    unsigned ok = 1u;
#pragma unroll
    for (unsigned j = 0; j < 16; ++j) { const unsigned c = xb_ld(&bar[XB_XCNT(j)]); ok &= (j < 8u) ? (c == 32u) : (c == 0u); }
    return ok;
}
__device__ __forceinline__ void xcd_barrier(const XcdBarrier& b) {
    asm volatile("s_waitcnt vmcnt(0)" ::: "memory");
    __syncthreads();
    if (threadIdx.x == 0) {
        unsigned* bar = b.bar;
        __builtin_amdgcn_s_waitcnt(0);
        unsigned nloc = b.st[0], nx = b.st[1];
        if (nloc == 0u) { xcd_barrier_complete(bar, b.x, nloc, nx); b.st[0] = nloc; b.st[1] = nx; b.st[3] = xcd_census_uniform(bar); }
        const unsigned old = xb_add(&bar[XB_XSUB(b.x)], 1u);
        const unsigned gen = old / nloc;
        if (old + 1u == (gen + 1u) * nloc) {
            __builtin_amdgcn_fence(__ATOMIC_RELEASE, "agent");
            asm volatile("s_waitcnt vmcnt(0)" ::: "memory");
            const unsigned og = xb_add(&bar[XB_TOP], 1u);
            const unsigned tg = og / nx;
            if (og + 1u == (tg + 1u) * nx) xb_add(&bar[XB_TOPGEN], 1u);
            else XB_SPIN(xb_ld(&bar[XB_TOPGEN]) == tg, bar);
            __builtin_amdgcn_fence(__ATOMIC_ACQUIRE, "agent");
            xb_add(&bar[XB_XGEN(b.x)], 1u);
            asm volatile("s_waitcnt vmcnt(0)" ::: "memory");
        } else {
            XB_SPIN(xb_ld(&bar[XB_XGEN(b.x)]) == gen, bar);
            __builtin_amdgcn_fence(__ATOMIC_ACQUIRE, "agent");
            asm volatile("s_waitcnt vmcnt(0)" ::: "memory");
        }
    }
    __syncthreads();
}

#define XB_LSUB(j)  (3520 + 64 * (j))
#define XB_LGEN(j)  (4544 + 64 * (j))
__device__ __forceinline__ void xcd_local_barrier(const XcdBarrier& b) {
    asm volatile("s_waitcnt vmcnt(0)" ::: "memory");
    __syncthreads();
    if (threadIdx.x == 0) {
        unsigned* bar = b.bar;
        __builtin_amdgcn_s_waitcnt(0);
        const unsigned old = xb_add(&bar[XB_LSUB(b.x)], 1u);
        const unsigned gen = old / 32u;
        if (old + 1u == (gen + 1u) * 32u) xb_add(&bar[XB_LGEN(b.x)], 1u);
        else XB_SPIN(xb_ld(&bar[XB_LGEN(b.x)]) == gen, bar);
        __builtin_amdgcn_fence(__ATOMIC_ACQUIRE, "agent");
        asm volatile("s_waitcnt vmcnt(0)" ::: "memory");
    }
    __syncthreads();
}

constexpr int NPHASES = 2 + NL * 10;
__global__ void __launch_bounds__(NTHREADS, 2) fwd_kernel(Params p) {
    extern __shared__ __attribute__((aligned(16))) unsigned char lds_raw[];
    LAS unsigned char* lds = (LAS unsigned char*)lds_raw;
    cg::grid_group grid = cg::this_grid();
    const int G = gridDim.x;
    volatile LAS unsigned* bst = (volatile LAS unsigned*)(lds + LDS_STAGE);
    if (threadIdx.x == 0) { bst[0] = 0u; bst[1] = 0u; bst[2] = 0u; bst[3] = 0u; }
    __syncthreads();
    XcdBarrier xbar; xbar.bar = (unsigned*)(p.ws + OFF_BAR); xbar.x = xb_xcc_id(); xbar.st = bst;
    if (threadIdx.x == 0) bst[2] = xb_add(&xbar.bar[XB_XCNT(xbar.x)], 1u);
    int vc = (int)blockIdx.x; bool local = false;
    bf16_t* WGU = (bf16_t*)(p.ws + OFF_WGU); bf16_t* WD = (bf16_t*)(p.ws + OFF_WD); bf16_t* WA = (bf16_t*)(p.ws + OFF_WA); bf16_t* WB = (bf16_t*)(p.ws + OFF_WB);
    bf16_t* WO = (bf16_t*)(p.ws + OFF_WO); bf16_t* TM = (bf16_t*)(p.ws + OFF_TM); bf16_t* H = (bf16_t*)(p.ws + OFF_H); bf16_t* Y = (bf16_t*)(p.ws + OFF_Y);
    bf16_t* HID = (bf16_t*)(p.ws + OFF_HID); bf16_t* PT = (bf16_t*)(p.ws + OFF_PT); bf16_t* Q = (bf16_t*)(p.ws + OFF_Q); bf16_t* YC = (bf16_t*)(p.ws + OFF_YCAT);
    bf16_t* HF = (bf16_t*)(p.ws + OFF_HF); float* NYQ = (float*)(p.ws + OFF_NYQ);

    for (int ph = p.ph_lo; ph < p.ph_hi; ++ph) {
        if (ph > p.ph_lo) {
            if (p.ph_hi < 0) grid.sync();
            else if (local && ph > 2) xcd_local_barrier(xbar);
            else xcd_barrier(xbar);
            if (XCD_LOCAL && ph == 2 && p.ph_lo == 0) { local = (__builtin_amdgcn_readfirstlane((int)bst[3]) != 0);
                if (local) { vc = __builtin_amdgcn_readfirstlane((int)bst[2]) * 8 + (int)xbar.x;
                    unsigned char* slice = p.ws + OFF_HID + (size_t)xbar.x * ((size_t)4096 * FF * 2);
                    PT = (bf16_t*)(slice - (size_t)xbar.x * ((size_t)4 << 20));
                    Q = (bf16_t*)(slice + ((size_t)4 << 20) - (size_t)xbar.x * ((size_t)4 << 20));
                    YC = (bf16_t*)(slice + ((size_t)8 << 20) - (size_t)xbar.x * ((size_t)8 << 20)); HF = YC; } }
        }
        if (ph == 0) {
            for (int rep = 0; rep < PREP_REPS; ++rep) {
            transpose_phase(p, lds, G);
            tm_phase(p, G);
            mcs_phase(p, lds, G);
            }
            norm_phase(nullptr, p.in[0], p.out, H, nullptr, nullptr, p.in[1], 0.f, G, (int)blockIdx.x);
            continue;
        }
        if (ph == 1) { for (int rep = 0; rep < FOLD_REPS; ++rep) fold_phase(p, lds, G); continue; }
        const int l = (ph - 2) / 10, s = (ph - 2) % 10;
        if (s == 0 || s == 7) {
            const int f = (s == 7);
            pg8::Gemm g{H, WGU + (size_t)(l * 2 + f) * 5632 * 1024, NTOK, 5632, 1024};
            pg8::Order S; S.init(NTOK, 5632, G, vc, 0, G1_WGM);
            pg8::EpiSwiGLU E{HID, 0};
            for (int rep = 0; rep < GEMM_REPS; ++rep) { E.dry = (rep > 0 && p.ph_lo >= 0); pg8::gemm_phase<pg8::EpiSwiGLU, pg8::Order, true, true>(lds, g, S, E); }
        } else if (s == 2 || s == 6 || s == 9) {
            const float* gpost = (s == 2 ? p.in[5] : s == 6 ? p.in[12] : p.in[17]) + (size_t)l * DM;
            const float* gpre = (s == 2 ? p.in[6] + (size_t)l * DM : s == 6 ? p.in[13] + (size_t)l * DM : p.in[1] + (size_t)(l + 1) * DM);
            const bool fin = (s == 9 && l == NL - 1);
            norm_phase(Y, p.out, p.out, fin ? nullptr : H, s == 2 ? HF : nullptr, gpost, gpre, s == 6 ? 1.0f : 0.5f, G, vc);
        } else {
            const int nsub = (s == 3) ? 2 : 1;
            if (s == 3) nyq_phase(WA + (size_t)l * 1024 * 1024, H, NYQ, G, vc);
            for (int sub = 0; sub < nsub; ++sub) {
                pg8::Gemm g; pg8::Order S; pg8::EpiMap E;
                if (s == 1 || s == 8) { const int f = (s == 8); g = pg8::Gemm{HID, WD + (size_t)(l * 2 + f) * 1024 * 2816, NTOK, 1024, 2816}; S.init(NTOK, 1024, G, vc, 0); E = pg8::EpiMap{Y, 1024, 0, 0, nullptr}; }
                else if (s == 3 && sub == 0) { g = pg8::Gemm{WA + (size_t)l * 1024 * 1024, HF, 1024, NTOK, 1024}; S.init(1024, NTOK, G, vc, 2); E = pg8::EpiMap{PT, 2048, 1, 0, nullptr}; }
                else if (s == 3) { g = pg8::Gemm{H, WB + (size_t)l * 512 * 1024, NTOK, 512, 1024}; S.init(NTOK, 512, G, vc, 0); E = pg8::EpiMap{Q, 512, 0, 0, nullptr}; }
                else if (s == 4) { g = pg8::Gemm{TM, PT, 2048, 8192, 2048}; S.init(2048, 8192, G, vc, 1); E = pg8::EpiMap{YC, 1024, 2, 0, NYQ}; }
                else { g = pg8::Gemm{YC, WO + (size_t)l * 1024 * 1024, NTOK, 1024, 1024}; S.init(NTOK, 1024, G, vc, 0); E = pg8::EpiMap{Y, 1024, 0, 0, nullptr}; }
                for (int rep = 0; rep < GEMM_REPS; ++rep) { E.dry = (rep > 0 && p.ph_lo >= 0); pg8::gemm_phase<pg8::EpiMap, pg8::Order, true, true>(lds, g, S, E); }
            }
            if (s == 4) for (int rep = 0; rep < POOL_REPS; ++rep) pool_phase(Q, YC, lds, G, vc);
        }
    }
}

extern "C" void kernel_launch(void* const* d_in, const int* in_sizes, int n_in, void* d_out, int out_size, void* d_ws, size_t ws_size, hipStream_t stream) {
    static int grid = 0;
    if (grid == 0) {
        if (n_in != 18 || out_size != NTOK * DM || ws_size < WS_END) { fprintf(stderr, "kernel_launch: unexpected shapes (n_in %d out %d ws %zu need %zu)\n", n_in, out_size, ws_size, (size_t)WS_END); grid = -1; return; }
        int dev = 0, cus = 0, per_cu = 0;
        hipGetDevice(&dev); hipDeviceGetAttribute(&cus, hipDeviceAttributeMultiprocessorCount, dev);
        if (hipFuncSetAttribute((const void*)fwd_kernel, hipFuncAttributeMaxDynamicSharedMemorySize, LDS_BYTES) != hipSuccess) { fprintf(stderr, "kernel_launch: hipFuncSetAttribute failed\n"); grid = -1; return; }
        if (hipOccupancyMaxActiveBlocksPerMultiprocessor(&per_cu, (const void*)fwd_kernel, NTHREADS, LDS_BYTES) != hipSuccess || per_cu < 1) { fprintf(stderr, "kernel_launch: occupancy query says %d\n", per_cu); per_cu = 1; }
        (void)hipGetLastError();
        grid = cus * per_cu;
        fprintf(stderr, "kernel_launch: grid %d (cus %d x %d)\n", grid, cus, per_cu);
    }
    if (grid < 0) return;
    if (hipMemsetAsync((char*)d_ws + OFF_BAR, 0, SZ_BAR, stream) != hipSuccess) { fprintf(stderr, "kernel_launch: memset failed\n"); return; }
    Params p{};
    for (int i = 0; i < 18; ++i) p.in[i] = (const float*)d_in[i];
    p.out = (float*)d_out; p.ws = (unsigned char*)d_ws;
#if MULTI_LAUNCH
    for (int ph = 0; ph < NPHASES; ++ph) { p.ph_lo = ph; p.ph_hi = ph + 1; hipLaunchKernelGGL(fwd_kernel, dim3(grid), dim3(NTHREADS), LDS_BYTES, stream, p); }
#else
    p.ph_lo = 0; p.ph_hi = NPHASES;
    void* args[] = {&p};
    hipError_t e = hipLaunchCooperativeKernel((const void*)fwd_kernel, dim3(grid), dim3(NTHREADS), args, LDS_BYTES, stream);
    if (e != hipSuccess) fprintf(stderr, "kernel_launch: cooperative launch failed: %s (grid %d)\n", hipGetErrorString(e), grid);
#endif
}
```

```cpp
#include <hip/hip_runtime.h>
#include <hip/hip_cooperative_groups.h>
#include <cstdio>
#include <cstdint>
namespace cg = cooperative_groups;

#ifndef GEMM_REPS
#define GEMM_REPS 1
#endif
#ifndef NORM_REPS
#define NORM_REPS 1
#endif
#ifndef POOL_REPS
#define POOL_REPS 1
#endif
#ifndef FOLD_REPS
#define FOLD_REPS 1
#endif
#ifndef G1_WGM
#define G1_WGM 4
#endif
#ifndef XCD_LOCAL
#define XCD_LOCAL 1
#endif
#ifndef STAGGER_TICKS
#define STAGGER_TICKS 0
#endif
#ifndef PREP_REPS
#define PREP_REPS 1
#endif
#ifndef MULTI_LAUNCH
#define MULTI_LAUNCH 0
#endif

#define LAS __attribute__((address_space(3)))
typedef unsigned short bf16_t;
typedef short bf16x8 __attribute__((ext_vector_type(8)));
typedef float f32x4 __attribute__((ext_vector_type(4)));
typedef unsigned u32x4 __attribute__((ext_vector_type(4)));
typedef unsigned u32x2 __attribute__((ext_vector_type(2)));

__device__ __forceinline__ int tid_opaque() { int t; asm volatile("v_mov_b32 %0, %1" : "=v"(t) : "v"(threadIdx.x)); return t; }

constexpr int NTOK = 32768, DM = 1024, FF = 2816, NL = 4, SEQ = 2048, NB = 16;
constexpr float EPS = 1e-6f;
constexpr int NTHREADS = 512;
constexpr int LDS_STAGE = 131072;
constexpr int LDS_BYTES = LDS_STAGE + 16;

constexpr size_t SZ_WGU = (size_t)NL * 2 * 5632 * 1024 * 2;
constexpr size_t SZ_WD = (size_t)NL * 2 * 1024 * 2816 * 2;
constexpr size_t SZ_WA = (size_t)NL * 1024 * 1024 * 2;
constexpr size_t SZ_WB = (size_t)NL * 512 * 1024 * 2;
constexpr size_t SZ_WO = (size_t)NL * 1024 * 1024 * 2;
constexpr size_t SZ_TM = (size_t)2048 * 2048 * 2;
constexpr size_t SZ_MCS = (size_t)NL * 4 * 128 * 256 * 4;
constexpr size_t SZ_H = (size_t)NTOK * 1024 * 2;
constexpr size_t SZ_Y = (size_t)NTOK * 1024 * 2;
constexpr size_t SZ_HID = (size_t)NTOK * 2816 * 2;
constexpr size_t OFF_WGU = 0;
constexpr size_t OFF_WD = OFF_WGU + SZ_WGU;
constexpr size_t OFF_WA = OFF_WD + SZ_WD;
constexpr size_t OFF_WB = OFF_WA + SZ_WA;
constexpr size_t OFF_WO = OFF_WB + SZ_WB;
constexpr size_t OFF_TM = OFF_WO + SZ_WO;
constexpr size_t OFF_MCS = OFF_TM + SZ_TM;
constexpr size_t OFF_H = OFF_MCS + SZ_MCS;
constexpr size_t OFF_Y = OFF_H + SZ_H;
constexpr size_t OFF_HID = OFF_Y + SZ_Y;
constexpr size_t OFF_PT = OFF_HID;
constexpr size_t SZ_PT = (size_t)NB * 512 * 2048 * 2;
constexpr size_t OFF_Q = OFF_PT + SZ_PT;
constexpr size_t SZ_Q = (size_t)NTOK * 512 * 2;
constexpr size_t OFF_YCAT = OFF_Q + SZ_Q;
constexpr size_t SZ_YCAT = (size_t)NTOK * 1024 * 2;
constexpr size_t OFF_HF = OFF_YCAT;
constexpr size_t SZ_HF = (size_t)2 * NB * 1024 * 1024 * 2;
constexpr size_t OFF_BAR = OFF_HID + SZ_HID;
constexpr size_t SZ_BAR = 32768;
constexpr size_t OFF_NYQ = OFF_BAR + SZ_BAR;
constexpr size_t SZ_NYQ = (size_t)NB * 512 * 4;
constexpr size_t WS_END = OFF_NYQ + SZ_NYQ;
static_assert(OFF_YCAT + SZ_YCAT <= OFF_BAR && OFF_HF + SZ_HF <= OFF_BAR, "alias region");

struct Params { const float* in[18]; float* out; unsigned char* ws; int ph_lo, ph_hi; };

namespace pg8 {
constexpr int BM = 256, BK = 64, HALF = 128, HTB = HALF * BK * 2, STAGE_BYTES = 8 * HTB, NXCD = 8, WGM = 8;
__host__ __device__ __forceinline__ int lds_byte(int r, int c) { const int st = (r >> 4) * 2 + (c >> 5), rr = r & 15, cc = c & 31, ob = rr * 64 + cc * 2; return st * 1024 + (ob ^ (((ob >> 9) & 1) << 5)); }
__host__ __device__ __forceinline__ void stage_rc(int b, int& R, int& C) { const int st = b / 1024, sb = b % 1024, swz = sb ^ (((sb >> 9) & 1) << 5); R = (st >> 1) * 16 + swz / 64; C = (st & 1) * 32 + (swz % 64) / 2; }
__host__ __device__ __forceinline__ int perm32(int rho) { const int n = rho >> 4, i = rho & 15; return 8 * (i >> 2) + 4 * n + (i & 3); }

struct Unit { int pm, pn; };
struct Gemm { const bf16_t* A; const bf16_t* Bt; int M, N, K; int ablk; };

struct Order {
    int nM, nN, nwg, G, c, mode, wgm;
    __device__ void init(int M, int N, int G_, int c_, int mode_, int wgm_ = WGM) { nM = M / BM; nN = N / BM; nwg = (mode_ == 2) ? 256 : nM * nN; G = G_; c = c_; mode = mode_; wgm = wgm_; }
    __device__ bool next(int i, Unit& u) const {
        const long L = (long)i * G + c; if (L >= nwg) return false;
        if (mode == 1) { const int xcd = (int)L & 7, j = (int)L >> 3; const int b = 2 * xcd + (j >> 4); u.pn = b * 2 + ((j >> 3) & 1); u.pm = j & 7; return true; }
        if (mode == 2) { const int x = (int)L & 7, i = (int)L >> 3, part = i >> 4, b = 2 * x + ((i >> 3) & 1); u.pm = part * 2 + (i & 1); u.pn = b * 8 + part * 4 + ((i >> 1) & 3); return true; }
        int wgid = (int)L; { const int q = nwg / NXCD, r = nwg % NXCD, xcd = wgid % NXCD, off = wgid / NXCD; wgid = (xcd < r ? xcd * (q + 1) : r * (q + 1) + (xcd - r) * q) + off; }
        const int nig = wgm * nN, gid = wgid / nig, fm = gid * wgm, gsz = (nM - fm) < wgm ? (nM - fm) : wgm;
        u.pm = fm + ((wgid % nig) % gsz); u.pn = (wgid % nig) / gsz; return true;
    }
    __device__ __forceinline__ void a_ready(const Unit&) const {}
    __device__ __forceinline__ void done(const Unit&) const {}
};

__device__ __forceinline__ unsigned cvt_pk_bf16(float lo, float hi) { unsigned r; asm volatile("v_cvt_pk_bf16_f32 %0, %1, %2" : "=v"(r) : "v"(lo), "v"(hi)); return r; }

struct EpiMap {
    static constexpr bool PERM = true, AFTER_DRAIN = false;
    bf16_t* O; int ldc; int mode; int dry; const float* nyq;
    __device__ __forceinline__ void operator()(const f32x4 (&acc)[2][2][4][2], const Unit& u, int wr, int wc, int fr, int fq) const {
        if (dry) return;
        size_t tb; int ld = ldc;
        if (mode == 0) tb = (size_t)u.pm * 256 * (size_t)ldc + (size_t)u.pn * 256;
        else if (mode == 1) { tb = ((size_t)((u.pn >> 3) * 512 + (u.pm & 1) * 256)) * 2048 + (size_t)((u.pm >> 1) * 1024 + (u.pn & 3) * 256); ld = 2048; }
        else { tb = ((size_t)((u.pn >> 1) * 2048 + u.pm * 256)) * 1024 + (size_t)((u.pn & 1) * 256); ld = 1024; }
        bf16_t* base = O + tb + (size_t)(wr * 64 + fr) * ld + wc * 32 + 8 * fq;
#pragma unroll
        for (int ai = 0; ai < 2; ++ai)
#pragma unroll
            for (int m = 0; m < 4; ++m) { bf16_t* rowp = base + (size_t)(ai * HALF + m * 16) * ld;
#pragma unroll
                for (int bj = 0; bj < 2; ++bj) { f32x4 v0 = acc[ai][bj][m][0], v1 = acc[ai][bj][m][1];
                    if (mode == 2) { const float* q = nyq + (u.pn >> 1) * 512 + (u.pn & 1) * 256 + bj * HALF + wc * 32 + 8 * fq; const float sg = (fr & 1) ? (-1.0f / 512.0f) : (1.0f / 512.0f);
                        v0 += *(const f32x4*)q * sg; v1 += *(const f32x4*)(q + 4) * sg; }
                    u32x4 w; w.x = cvt_pk_bf16(v0[0], v0[1]); w.y = cvt_pk_bf16(v0[2], v0[3]); w.z = cvt_pk_bf16(v1[0], v1[1]); w.w = cvt_pk_bf16(v1[2], v1[3]);
                    *(u32x4*)(rowp + bj * HALF) = w; } }
    }
};
__device__ __forceinline__ float silu_mul(float a, float b) { return (a * b) * __builtin_amdgcn_rcpf(1.0f + __builtin_amdgcn_exp2f(-a)); }
struct EpiSwiGLU {
    static constexpr bool PERM = true, AFTER_DRAIN = false;
    bf16_t* O; int dry;
    __device__ __forceinline__ void operator()(const f32x4 (&acc)[2][2][4][2], const Unit& u, int wr, int wc, int fr, int fq) const {
        if (dry) return;
        bf16_t* base = O + ((size_t)(u.pm * (FF / 64) + u.pn * 2 + (wc >> 1)) * 256 + wr * 64 + fr) * 64 + (wc & 1) * 32 + 8 * fq;
#pragma unroll
        for (int ai = 0; ai < 2; ++ai)
#pragma unroll
            for (int m = 0; m < 4; ++m) { bf16_t* rowp = base + (size_t)(ai * HALF + m * 16) * 64;
                const f32x4 g0 = acc[ai][0][m][0], g1 = acc[ai][0][m][1], u0 = acc[ai][1][m][0], u1 = acc[ai][1][m][1];
                u32x4 w; w.x = cvt_pk_bf16(silu_mul(g0[0], u0[0]), silu_mul(g0[1], u0[1])); w.y = cvt_pk_bf16(silu_mul(g0[2], u0[2]), silu_mul(g0[3], u0[3]));
                w.z = cvt_pk_bf16(silu_mul(g1[0], u1[0]), silu_mul(g1[1], u1[1])); w.w = cvt_pk_bf16(silu_mul(g1[2], u1[2]), silu_mul(g1[3], u1[3]));
                *(u32x4*)rowp = w; }
    }
};

template <class Epi, class Sched, bool ALIGN_EPI = false, bool SP2 = false>
__device__ __forceinline__ void gemm_phase(LAS unsigned char* lds, const Gemm g, const Sched& S, const Epi& E) {
    const int tid = tid_opaque(), wid = __builtin_amdgcn_readfirstlane(tid >> 6), lane = tid & 63, wr = wid >> 2, wc = wid & 3, fr = lane & 15, fq = lane >> 4;
    const int K = g.K, nt = K / BK;
    unsigned voffA[2], voffB[2];
#pragma unroll
    for (int i = 0; i < 2; ++i) { int R, C; stage_rc(tid * 16 + i * 8192, R, C); const int Rb = Epi::PERM ? ((R & ~31) + perm32(R & 31)) : R;
        voffA[i] = (unsigned)(R * (g.ablk ? BK : K) + C) * 2u; voffB[i] = (unsigned)(Rb * K + C) * 2u; }
    const size_t kstep = (size_t)(BK * 2);
    const size_t hstep = (size_t)HALF * K * 2;
    const size_t tstep = 2 * hstep;
    const size_t kstepA = g.ablk ? (size_t)BM * BK * 2 : kstep, hstepA = g.ablk ? (size_t)HALF * BK * 2 : hstep;
    const unsigned ldsw = (unsigned)wid * 1024u;
    const int aoff = lds_byte(wr * 64 + fr, fq * 8), boff = lds_byte(wc * 32 + fr, fq * 8);
#define PG8_SA(b, h) (((b) * 2 + (h)) * HTB)
#define PG8_SB(b, h) ((4 + (b) * 2 + (h)) * HTB)
#define PG8_STAGE(bufoff, gbase, voff) do { _Pragma("unroll") for (int _i = 0; _i < 2; ++_i) \
        __builtin_amdgcn_global_load_lds((const unsigned*)((const char*)(gbase) + (voff)[_i]), (LAS unsigned*)(lds + (bufoff) + ldsw + _i * 8192), 16, 0, 0); } while (0)
#define PG8_LDA(dst, b, h) do { _Pragma("unroll") for (int m = 0; m < 4; ++m) _Pragma("unroll") for (int k = 0; k < 2; ++k) dst[m][k] = *(const LAS bf16x8*)(lds + PG8_SA(b, h) + aoff + m * 2048 + k * 1024); } while (0)
#define PG8_LDB(dst, b, h) do { _Pragma("unroll") for (int n = 0; n < 2; ++n) _Pragma("unroll") for (int k = 0; k < 2; ++k) dst[n][k] = *(const LAS bf16x8*)(lds + PG8_SB(b, h) + boff + n * 2048 + k * 1024); } while (0)
#define PG8_MMA(ai, bj, At, Bt) do { __builtin_amdgcn_s_setprio(1); _Pragma("unroll") for (int m = 0; m < 4; ++m) _Pragma("unroll") for (int n = 0; n < 2; ++n) _Pragma("unroll") for (int k = 0; k < 2; ++k) \
        acc[ai][bj][m][n] = __builtin_amdgcn_mfma_f32_16x16x32_bf16(Bt[n][k], At[m][k], acc[ai][bj][m][n], 0, 0, 0); __builtin_amdgcn_s_setprio(0); } while (0)
#define PG8_WAIT_V(n) asm volatile("s_waitcnt vmcnt(" #n ")" ::: "memory")
#define PG8_WAIT_L(n) asm volatile("s_waitcnt lgkmcnt(" #n ")" ::: "memory")
#define PG8_BAR __builtin_amdgcn_s_barrier()
#define PG8_SCHED __builtin_amdgcn_sched_barrier(0)
    Unit cur, nxt; int ui = 0;
    if (!S.next(0, cur)) return;
    f32x4 acc[2][2][4][2];
#pragma unroll
    for (int a = 0; a < 2; ++a)
#pragma unroll
        for (int b = 0; b < 2; ++b)
#pragma unroll
            for (int m = 0; m < 4; ++m)
#pragma unroll
                for (int n = 0; n < 2; ++n) acc[a][b][m][n] = (f32x4){0.f, 0.f, 0.f, 0.f};
    bf16x8 At[4][2], B0[2][2], B1[2][2];
    const char* cA = (const char*)g.A + (size_t)cur.pm * tstep; const char* cB = (const char*)g.Bt + (size_t)cur.pn * tstep;
    S.a_ready(cur);
    if constexpr (SP2) {
        PG8_STAGE(PG8_SB(0, 0), cB, voffB); PG8_STAGE(PG8_SB(0, 1), cB + hstep, voffB); PG8_STAGE(PG8_SA(0, 0), cA, voffA); PG8_STAGE(PG8_SA(0, 1), cA + hstepA, voffA);
        if (wr == 1) PG8_BAR;
        PG8_WAIT_V(2); PG8_BAR;
        PG8_STAGE(PG8_SB(1, 0), cB + kstep, voffB); PG8_STAGE(PG8_SA(1, 0), cA + kstepA, voffA); PG8_STAGE(PG8_SB(1, 1), cB + hstep + kstep, voffB);
        PG8_WAIT_V(6); PG8_BAR;
    } else {
        PG8_STAGE(PG8_SB(0, 0), cB, voffB); PG8_STAGE(PG8_SA(0, 0), cA, voffA); PG8_STAGE(PG8_SB(0, 1), cB + hstep, voffB); PG8_STAGE(PG8_SA(0, 1), cA + hstep, voffA);
        if (wr == 1) PG8_BAR;
        PG8_WAIT_V(4); PG8_BAR;
        PG8_STAGE(PG8_SB(1, 0), cB + kstep, voffB); PG8_STAGE(PG8_SA(1, 0), cA + kstep, voffA); PG8_STAGE(PG8_SB(1, 1), cB + hstep + kstep, voffB);
        PG8_WAIT_V(6); PG8_BAR;
    }
    for (;;) {
        const bool has_next = S.next(ui + 1, nxt);
        const char* nA = has_next ? (const char*)g.A + (size_t)nxt.pm * tstep : cA; const char* nB = has_next ? (const char*)g.Bt + (size_t)nxt.pn * tstep : cB;
        for (int t = 0; t < nt; t += 2) {
            const bool last = (t == nt - 2);
            const char* a1 = cA + (size_t)(t + 1) * kstepA;
            const char* a2 = last ? nA : cA + (size_t)(t + 2) * kstepA; const char* b2 = last ? nB : cB + (size_t)(t + 2) * kstep;
            const char* a3 = a2 + kstepA; const char* b3 = b2 + kstep;
            if (last && has_next) S.a_ready(nxt);
            if constexpr (SP2) {
            PG8_LDB(B0, 0, 0); PG8_LDB(B1, 0, 1); PG8_SCHED; PG8_LDA(At, 0, 0); PG8_STAGE(PG8_SA(1, 1), a1 + hstepA, voffA);
            PG8_WAIT_V(8); PG8_WAIT_L(0); PG8_BAR; PG8_MMA(0, 0, At, B0); PG8_MMA(0, 1, At, B1); PG8_BAR; PG8_SCHED;
            PG8_LDA(At, 0, 1); PG8_STAGE(PG8_SB(0, 0), b2, voffB); PG8_STAGE(PG8_SB(0, 1), b2 + hstep, voffB); PG8_STAGE(PG8_SA(0, 0), a2, voffA);
            PG8_WAIT_V(8); PG8_WAIT_L(0); PG8_BAR; PG8_MMA(1, 0, At, B0); PG8_MMA(1, 1, At, B1); PG8_BAR; PG8_SCHED;
            PG8_LDB(B0, 1, 0); PG8_LDB(B1, 1, 1); PG8_SCHED; PG8_LDA(At, 1, 0); PG8_STAGE(PG8_SA(0, 1), a2 + hstepA, voffA);
            PG8_WAIT_V(8); PG8_WAIT_L(0); PG8_BAR; PG8_MMA(0, 0, At, B0); PG8_MMA(0, 1, At, B1); PG8_BAR; PG8_SCHED;
            PG8_LDA(At, 1, 1); PG8_STAGE(PG8_SB(1, 0), b3, voffB); PG8_STAGE(PG8_SB(1, 1), b3 + hstep, voffB); PG8_STAGE(PG8_SA(1, 0), a3, voffA);
            PG8_WAIT_V(8); PG8_WAIT_L(0); PG8_BAR; PG8_MMA(1, 0, At, B0); PG8_MMA(1, 1, At, B1); PG8_BAR; PG8_SCHED;
            } else {
            PG8_LDB(B0, 0, 0); PG8_SCHED; PG8_LDA(At, 0, 0); PG8_STAGE(PG8_SA(1, 1), a1 + hstep, voffA);
            PG8_WAIT_L(8); PG8_BAR; PG8_WAIT_L(0); PG8_MMA(0, 0, At, B0); PG8_BAR; PG8_SCHED;
            PG8_LDB(B1, 0, 1); PG8_STAGE(PG8_SB(0, 0), b2, voffB);
            PG8_BAR; PG8_WAIT_L(0); PG8_MMA(0, 1, At, B1); PG8_BAR;
            PG8_LDA(At, 0, 1); PG8_STAGE(PG8_SA(0, 0), a2, voffA);
            PG8_BAR; PG8_WAIT_L(0); PG8_MMA(1, 0, At, B0); PG8_BAR; PG8_SCHED;
            PG8_STAGE(PG8_SB(0, 1), b2 + hstep, voffB);
            PG8_WAIT_V(6); PG8_BAR; PG8_MMA(1, 1, At, B1); PG8_BAR;
            PG8_LDB(B0, 1, 0); PG8_SCHED; PG8_LDA(At, 1, 0); PG8_STAGE(PG8_SA(0, 1), a2 + hstep, voffA);
            PG8_WAIT_L(8); PG8_BAR; PG8_WAIT_L(0); PG8_MMA(0, 0, At, B0); PG8_BAR; PG8_SCHED;
            PG8_LDB(B1, 1, 1); PG8_STAGE(PG8_SB(1, 0), b3, voffB);
            PG8_BAR; PG8_WAIT_L(0); PG8_MMA(0, 1, At, B1); PG8_BAR;
            PG8_LDA(At, 1, 1); PG8_STAGE(PG8_SA(1, 0), a3, voffA);
            PG8_BAR; PG8_WAIT_L(0); PG8_MMA(1, 0, At, B0); PG8_BAR; PG8_SCHED;
            PG8_STAGE(PG8_SB(1, 1), b3 + hstep, voffB);
            PG8_WAIT_V(6); PG8_BAR; PG8_MMA(1, 1, At, B1); PG8_BAR;
            }
        }
        if constexpr (ALIGN_EPI) { if (wr == 0) PG8_BAR; }
        if constexpr (!Epi::AFTER_DRAIN) { E(acc, cur, wr, wc, fr, fq); S.done(cur); }
        if (!has_next) break;
#pragma unroll
        for (int a = 0; a < 2; ++a)
#pragma unroll
            for (int b = 0; b < 2; ++b)
#pragma unroll
                for (int m = 0; m < 4; ++m)
#pragma unroll
                    for (int n = 0; n < 2; ++n) acc[a][b][m][n] = (f32x4){0.f, 0.f, 0.f, 0.f};
        cur = nxt; cA = nA; cB = nB; ++ui;
        if constexpr (ALIGN_EPI) { if (wr == 1) PG8_BAR; }
    }
    PG8_WAIT_V(0);
    if constexpr (!ALIGN_EPI) { if (wr == 0) PG8_BAR; }
    PG8_BAR;
#undef PG8_SA
#undef PG8_SB
#undef PG8_STAGE
#undef PG8_LDA
#undef PG8_LDB
#undef PG8_MMA
#undef PG8_WAIT_V
#undef PG8_WAIT_L
#undef PG8_BAR
#undef PG8_SCHED
}
}

__device__ __forceinline__ float wave_sum(float v) {
    v += __shfl_xor(v, 32); v += __shfl_xor(v, 16); v += __shfl_xor(v, 8); v += __shfl_xor(v, 4); v += __shfl_xor(v, 2); v += __shfl_xor(v, 1); return v;
}
__device__ __forceinline__ float bf_lo(unsigned u) { return __uint_as_float(u << 16); }
__device__ __forceinline__ float bf_hi(unsigned u) { return __uint_as_float(u & 0xffff0000u); }

struct NormRows { f32x4 x0[4], x1[4]; u32x2 y0[4], y1[4]; };
__device__ __forceinline__ void norm_rows_of(int qq, int& bk, int& r0, int& r1) {
    const int x = (qq >> 3) & 7, pl = ((qq >> 6) << 3) | (qq & 7), b = 2 * x + (pl >> 10), k = pl & 1023;
    bk = b * 1024 + k; r0 = b * SEQ + k; r1 = b * SEQ + (k == 0 ? SEQ / 2 : SEQ - k);
}
__device__ __forceinline__ void norm_load(NormRows& r, const bf16_t* y, const float* xin, int r0, int r1, int lane, bool has_y) {
    const size_t o0 = (size_t)r0 * DM + lane * 4, o1 = (size_t)r1 * DM + lane * 4;
#pragma unroll
    for (int j = 0; j < 4; ++j) { r.x0[j] = __builtin_nontemporal_load((const f32x4*)(xin + o0 + 256 * j)); r.x1[j] = __builtin_nontemporal_load((const f32x4*)(xin + o1 + 256 * j)); }
    if (has_y) {
#pragma unroll
        for (int j = 0; j < 4; ++j) { r.y0[j] = __builtin_nontemporal_load((const u32x2*)(y + o0 + 256 * j)); r.y1[j] = __builtin_nontemporal_load((const u32x2*)(y + o1 + 256 * j)); }
    }
}
__device__ __forceinline__ void norm_phase(const bf16_t* y, const float* xin, float* xout, bf16_t* h, bf16_t* hf, const float* gpost, const float* gpre, float coef, int G, int c) {
    const int tid = tid_opaque(); const int lane = tid & 63, wid = tid >> 6;
    const int gw = c * 8 + wid, nw = G * 8;
    const bool has_y = (y != nullptr), has_h = (h != nullptr), fold = (hf != nullptr);
    f32x4 gp[4], gq[4];
#pragma unroll
    for (int j = 0; j < 4; ++j) {
        gp[j] = has_y ? *(const f32x4*)(gpost + lane * 4 + 256 * j) : (f32x4){0.f, 0.f, 0.f, 0.f};
        gq[j] = has_h ? *(const f32x4*)(gpre + lane * 4 + 256 * j) : (f32x4){0.f, 0.f, 0.f, 0.f};
    }
    NormRows cur, nxt;
    int r0, r1, bk;
    if (gw < NTOK / 2) { norm_rows_of(gw, bk, r0, r1); norm_load(cur, y, xin, r0, r1, lane, has_y); }
    for (int q = gw; q < NTOK / 2; q += nw) {
        norm_rows_of(q, bk, r0, r1);
        if (q + nw < NTOK / 2) { int n0, n1, nb; norm_rows_of(q + nw, nb, n0, n1); norm_load(nxt, y, xin, n0, n1, lane, has_y); }
        const size_t o0 = (size_t)r0 * DM + lane * 4, o1 = (size_t)r1 * DM + lane * 4;
        f32x4 x0[4], x1[4];
#pragma unroll
        for (int j = 0; j < 4; ++j) { x0[j] = cur.x0[j]; x1[j] = cur.x1[j]; }
        if (has_y) {
            f32x4 v0[4], v1[4]; float s0 = 0.f, s1 = 0.f;
#pragma unroll
            for (int j = 0; j < 4; ++j) {
                v0[j] = (f32x4){bf_lo(cur.y0[j].x), bf_hi(cur.y0[j].x), bf_lo(cur.y0[j].y), bf_hi(cur.y0[j].y)};
                v1[j] = (f32x4){bf_lo(cur.y1[j].x), bf_hi(cur.y1[j].x), bf_lo(cur.y1[j].y), bf_hi(cur.y1[j].y)};
                s0 += (v0[j][0] * v0[j][0] + v0[j][1] * v0[j][1]) + (v0[j][2] * v0[j][2] + v0[j][3] * v0[j][3]);
                s1 += (v1[j][0] * v1[j][0] + v1[j][1] * v1[j][1]) + (v1[j][2] * v1[j][2] + v1[j][3] * v1[j][3]);
            }
            s0 = wave_sum(s0); s1 = wave_sum(s1);
            const float c0 = coef * rsqrtf(s0 * (1.0f / DM) + EPS), c1 = coef * rsqrtf(s1 * (1.0f / DM) + EPS);
#pragma unroll
            for (int j = 0; j < 4; ++j) { x0[j] += v0[j] * gp[j] * c0; x1[j] += v1[j] * gp[j] * c1; }
        }
        if (xout) {
#pragma unroll
            for (int j = 0; j < 4; ++j) { __builtin_nontemporal_store(x0[j], (f32x4*)(xout + o0 + 256 * j)); __builtin_nontemporal_store(x1[j], (f32x4*)(xout + o1 + 256 * j)); }
        }
        if (has_h) {
            float s0 = 0.f, s1 = 0.f;
#pragma unroll
            for (int j = 0; j < 4; ++j) {
                s0 += (x0[j][0] * x0[j][0] + x0[j][1] * x0[j][1]) + (x0[j][2] * x0[j][2] + x0[j][3] * x0[j][3]);
                s1 += (x1[j][0] * x1[j][0] + x1[j][1] * x1[j][1]) + (x1[j][2] * x1[j][2] + x1[j][3] * x1[j][3]);
            }
            s0 = wave_sum(s0); s1 = wave_sum(s1);
            const float c0 = rsqrtf(s0 * (1.0f / DM) + EPS), c1 = rsqrtf(s1 * (1.0f / DM) + EPS);
            const float fs = ((bk & 1023) == 0) ? 0.f : 1.f;
            const size_t oe = ((size_t)(bk >> 10) * 2048 + (bk & 1023)) * DM + lane * 4, oo = oe + (size_t)1024 * DM;
#pragma unroll
            for (int j = 0; j < 4; ++j) {
                const f32x4 a = x0[j] * gq[j] * c0, b = x1[j] * gq[j] * c1;
                u32x2 wa, wb; wa.x = pg8::cvt_pk_bf16(a[0], a[1]); wa.y = pg8::cvt_pk_bf16(a[2], a[3]); wb.x = pg8::cvt_pk_bf16(b[0], b[1]); wb.y = pg8::cvt_pk_bf16(b[2], b[3]);
                *(u32x2*)(h + o0 + 256 * j) = wa; *(u32x2*)(h + o1 + 256 * j) = wb;
                if (fold) { const f32x4 e = a + b * fs, o = (a - b) * fs;
                    u32x2 we, wo; we.x = pg8::cvt_pk_bf16(e[0], e[1]); we.y = pg8::cvt_pk_bf16(e[2], e[3]); wo.x = pg8::cvt_pk_bf16(o[0], o[1]); wo.y = pg8::cvt_pk_bf16(o[2], o[3]);
                    *(u32x2*)(hf + oe + 256 * j) = we; *(u32x2*)(hf + oo + 256 * j) = wo; }
            }
        }
        cur = nxt;
    }
}

struct TrJob { const float* src; bf16_t* dst; int N, tn, ldd, kind, t0; };
__device__ __forceinline__ TrJob tr_decode(const Params& p, int R) {
    constexpr int TPL = 4480;
    bf16_t* WGU = (bf16_t*)(p.ws + OFF_WGU); bf16_t* WD = (bf16_t*)(p.ws + OFF_WD); bf16_t* WO = (bf16_t*)(p.ws + OFF_WO);
    const int ti0 = R * 4, l = ti0 / TPL, r = ti0 % TPL; int m = r / 704; if (m > 6) m = 6;
    TrJob j; j.t0 = r - m * 704;
    if (m == 0) { j.src = p.in[2] + (size_t)l * 1024 * 2816; j.N = 2816; j.tn = 44; j.dst = WGU + (size_t)(l * 2 + 0) * 5632 * 1024; j.ldd = 1024; j.kind = 0; }
    else if (m == 1) { j.src = p.in[3] + (size_t)l * 1024 * 2816; j.N = 2816; j.tn = 44; j.dst = WGU + (size_t)(l * 2 + 0) * 5632 * 1024; j.ldd = 1024; j.kind = 1; }
    else if (m == 2) { j.src = p.in[4] + (size_t)l * 2816 * 1024; j.N = 1024; j.tn = 16; j.dst = WD + (size_t)(l * 2 + 0) * 1024 * 2816; j.ldd = 2816; j.kind = 2; }
    else if (m == 3) { j.src = p.in[14] + (size_t)l * 1024 * 2816; j.N = 2816; j.tn = 44; j.dst = WGU + (size_t)(l * 2 + 1) * 5632 * 1024; j.ldd = 1024; j.kind = 0; }
    else if (m == 4) { j.src = p.in[15] + (size_t)l * 1024 * 2816; j.N = 2816; j.tn = 44; j.dst = WGU + (size_t)(l * 2 + 1) * 5632 * 1024; j.ldd = 1024; j.kind = 1; }
    else if (m == 5) { j.src = p.in[16] + (size_t)l * 2816 * 1024; j.N = 1024; j.tn = 16; j.dst = WD + (size_t)(l * 2 + 1) * 1024 * 2816; j.ldd = 2816; j.kind = 2; }
    else { j.src = p.in[11] + (size_t)l * 1024 * 1024; j.N = 1024; j.tn = 16; j.dst = WO + (size_t)l * 1024 * 1024; j.ldd = 1024; j.kind = 2; }
    return j;
}
__device__ __forceinline__ void tr_load(f32x4 (&v)[4][2], const TrJob& j, int tid) {
#pragma unroll
    for (int q = 0; q < 4; ++q) { const int t = j.t0 + q, kt = t / j.tn, ntile = t - kt * j.tn;
#pragma unroll
        for (int i = 0; i < 2; ++i) v[q][i] = __builtin_nontemporal_load((const f32x4*)(j.src + (size_t)(kt * 64 + (tid >> 4) + 32 * i) * j.N + ntile * 64 + (tid & 15) * 4)); }
}
__device__ __forceinline__ void transpose_phase(const Params& p, LAS unsigned char* lds, int G) {
    LAS float* T = (LAS float*)lds;
    const int tid = tid_opaque();
    const int nrounds = NL * 4480 / 4;
    f32x4 v[4][2];
    TrJob cur, nxt;
    if ((int)blockIdx.x < nrounds) { cur = tr_decode(p, blockIdx.x); tr_load(v, cur, tid); }
    for (int R = blockIdx.x; R < nrounds; R += G) {
#pragma unroll
        for (int q = 0; q < 4; ++q)
#pragma unroll
            for (int i = 0; i < 2; ++i) { LAS float* d = T + q * 4160 + ((tid >> 4) + 32 * i) * 65 + (tid & 15) * 4; d[0] = v[q][i][0]; d[1] = v[q][i][1]; d[2] = v[q][i][2]; d[3] = v[q][i][3]; }
        __syncthreads();
        nxt = cur;
        if (R + G < nrounds) { nxt = tr_decode(p, R + G); tr_load(v, nxt, tid); }
#pragma unroll
        for (int q = 0; q < 4; ++q) { const int t = cur.t0 + q, kt = t / cur.tn, ntile = t - kt * cur.tn;
            const int nl = tid >> 3, k8 = (tid & 7) * 8; const int n = ntile * 64 + nl;
            const int drow = (cur.kind == 2) ? n : ((n >> 7) * 256 + (n & 127) + (cur.kind == 1 ? 128 : 0));
            const LAS float* s = T + q * 4160 + k8 * 65 + nl;
            const float sc = (cur.kind == 0) ? 1.4426950408889634f : (cur.kind == 1) ? 0.6931471805599453f : 1.0f;
            u32x4 w; w.x = pg8::cvt_pk_bf16(s[0] * sc, s[65] * sc); w.y = pg8::cvt_pk_bf16(s[130] * sc, s[195] * sc); w.z = pg8::cvt_pk_bf16(s[260] * sc, s[325] * sc); w.w = pg8::cvt_pk_bf16(s[390] * sc, s[455] * sc);
            *(u32x4*)(cur.dst + (size_t)drow * cur.ldd + kt * 64 + k8) = w; }
        __syncthreads();
        cur = nxt;
    }
}

__device__ __forceinline__ void tm_phase(const Params& p, int G) {
    bf16_t* TM = (bf16_t*)(p.ws + OFF_TM);
    const int total = 2048 * 2048 / 8; const int tid = tid_opaque();
    for (int e = blockIdx.x * NTHREADS + tid; e < total; e += G * NTHREADS) {
        const int s = e >> 8, k0 = (e & 255) * 8; float v[8];
#pragma unroll
        for (int j = 0; j < 8; ++j) { const int k = k0 + j, kk = k & 1023; const int ph = (s * kk) & 2047; const float a = (float)ph * (1.0f / 1024.0f);
            v[j] = (k < 1024) ? cospif(a) * (1.0f / 512.0f) : -sinpif(a) * (1.0f / 512.0f); }
        u32x4 w; w.x = pg8::cvt_pk_bf16(v[0], v[1]); w.y = pg8::cvt_pk_bf16(v[2], v[3]); w.z = pg8::cvt_pk_bf16(v[4], v[5]); w.w = pg8::cvt_pk_bf16(v[6], v[7]);
        *(u32x4*)(TM + (size_t)e * 8) = w;
    }
}

__device__ __forceinline__ void nyq_phase(const bf16_t* WA, const bf16_t* H, float* nyq, int G, int c) {
    const int tid = tid_opaque(), lane = tid & 63, wid = tid >> 6;
    for (int tt = c * 8 + wid; tt < NB * 512; tt += G * 8) {
        const int x = (tt >> 3) & 7, tl = ((tt >> 6) << 3) | (tt & 7), b = 2 * x + (tl >> 9), n = tl & 511, t = b * 512 + n;
        const bf16_t* w = WA + (size_t)n * 1024 + lane * 8; const bf16_t* h = H + ((size_t)b * SEQ + 1024) * 1024 + lane * 8;
        float acc = 0.f;
#pragma unroll
        for (int j = 0; j < 2; ++j) { const u32x4 a = *(const u32x4*)(w + 512 * j), c = *(const u32x4*)(h + 512 * j);
            acc += bf_lo(a.x) * bf_lo(c.x) + bf_hi(a.x) * bf_hi(c.x) + bf_lo(a.y) * bf_lo(c.y) + bf_hi(a.y) * bf_hi(c.y) + bf_lo(a.z) * bf_lo(c.z) + bf_hi(a.z) * bf_hi(c.z) + bf_lo(a.w) * bf_lo(c.w) + bf_hi(a.w) * bf_hi(c.w); }
        acc = wave_sum(acc);
        if (lane == 0) nyq[t] = acc;
    }
}

__device__ __forceinline__ void mcs_phase(const Params& p, LAS unsigned char* lds, int G) {
    LAS float* tab = (LAS float*)lds;
    const int tid = tid_opaque();
    if (tid < 128) { const float a = (float)tid * (1.0f / 64.0f); tab[tid] = cospif(a); tab[128 + tid] = sinpif(a); }
    __syncthreads();
    float* MCS = (float*)(p.ws + OFF_MCS); const float* fw = p.in[8];
    const int total = NL * 4 * 128 * 256;
    for (int e = blockIdx.x * NTHREADS + tid; e < total; e += G * NTHREADS) {
        const int col = e & 255, c = (e >> 8) & 127, lh = e >> 15; const int part = col >> 7, d = col & 127;
        const float* w = fw + (size_t)lh * 128 * 128 + d; float acc = 0.f;
        for (int k = 0; k < 128; ++k) acc += tab[part * 128 + ((c * k) & 127)] * w[(size_t)k * 128];
        MCS[e] = acc;
    }
    __syncthreads();
}

__device__ __forceinline__ void fold_phase(const Params& p, LAS unsigned char* lds, int G) {
    LAS float* Wt = (LAS float*)lds;
    LAS float* Mt = (LAS float*)(lds + 128 * 132 * 4);
    const int tid = tid_opaque();
    const float* MCS = (const float*)(p.ws + OFF_MCS);
    bf16_t* WA = (bf16_t*)(p.ws + OFF_WA); bf16_t* WB = (bf16_t*)(p.ws + OFF_WB);
    const int nitems = NL * 24 * 8;
    for (int it = blockIdx.x; it < nitems; it += G) {
        const int kb = it & 7, ch = (it >> 3) % 24, l = (it >> 3) / 24;
        const float* win = p.in[7] + (size_t)l * 1024 * 1024;
        const float* msrc; int ldm, wcol; bf16_t* dst; const float* scl = nullptr;
        if (ch < 16) { const int h = ch >> 2, cc = ch & 3; msrc = MCS + (size_t)(l * 4 + h) * 128 * 256 + cc * 64; ldm = 256; wcol = h * 128;
            dst = WA + ((size_t)l * 1024 + (cc >> 1) * 512 + h * 128 + (cc & 1) * 64) * 1024; }
        else { const int g = (ch - 16) >> 1, d0 = ((ch - 16) & 1) * 64; msrc = p.in[9] + (size_t)(l * 4 + g) * 128 * 128 + d0; ldm = 128; wcol = 512 + g * 128;
            dst = WB + ((size_t)l * 512 + g * 128 + d0) * 1024; scl = p.in[10] + (size_t)l * 512 + g * 128 + d0; }
#pragma unroll
        for (int i = 0; i < 8; ++i) { const int kk = (tid >> 5) + 16 * i, c4 = (tid & 31) * 4;
            *(LAS f32x4*)(Wt + kk * 132 + c4) = *(const f32x4*)(win + (size_t)(kb * 128 + kk) * 1024 + wcol + c4); }
#pragma unroll
        for (int i = 0; i < 4; ++i) { const int c = (tid >> 4) + 32 * i, j4 = (tid & 15) * 4;
            f32x4 mv = *(const f32x4*)(msrc + (size_t)c * ldm + j4);
            if (scl) mv *= *(const f32x4*)(scl + j4);
            *(LAS f32x4*)(Mt + c * 64 + j4) = mv; }
        __syncthreads();
        const int j4 = (tid & 15) * 4, k4 = (tid >> 4) * 4;
        f32x4 acc[4];
#pragma unroll
        for (int q = 0; q < 4; ++q) acc[q] = (f32x4){0.f, 0.f, 0.f, 0.f};
        for (int c4 = 0; c4 < 32; ++c4) {
            const f32x4 m0 = *(const LAS f32x4*)(Mt + (c4 * 4 + 0) * 64 + j4), m1 = *(const LAS f32x4*)(Mt + (c4 * 4 + 1) * 64 + j4);
            const f32x4 m2 = *(const LAS f32x4*)(Mt + (c4 * 4 + 2) * 64 + j4), m3 = *(const LAS f32x4*)(Mt + (c4 * 4 + 3) * 64 + j4);
#pragma unroll
            for (int q = 0; q < 4; ++q) { const f32x4 w = *(const LAS f32x4*)(Wt + (k4 + q) * 132 + c4 * 4); acc[q] += (m0 * w[0] + m1 * w[1]) + (m2 * w[2] + m3 * w[3]); }
        }
#pragma unroll
        for (int jj = 0; jj < 4; ++jj) { u32x2 w; w.x = pg8::cvt_pk_bf16(acc[0][jj], acc[1][jj]); w.y = pg8::cvt_pk_bf16(acc[2][jj], acc[3][jj]);
            *(u32x2*)(dst + (size_t)(j4 + jj) * 1024 + kb * 128 + k4) = w; }
        __syncthreads();
    }
}

template <int R> __device__ __forceinline__ void pool_group(const LAS unsigned char* tile, int tl, int s, int g, int c16, bf16_t* orow) {
    float a[8];
#pragma unroll
    for (int q = 0; q < 8; ++q) a[q] = 0.f;
    const LAS unsigned char* base = tile + (tl + 8 - R) * 1024 + g * 256 + c16 * 16;
    u32x4 c;
#pragma unroll
    for (int j = 0; j <= 2 * R; ++j) { const u32x4 v = *(const LAS u32x4*)(base + j * 1024); if (j == R) c = v;
        a[0] += bf_lo(v.x); a[1] += bf_hi(v.x); a[2] += bf_lo(v.y); a[3] += bf_hi(v.y); a[4] += bf_lo(v.z); a[5] += bf_hi(v.z); a[6] += bf_lo(v.w); a[7] += bf_hi(v.w); }
    const int lo = (s - R < 0) ? 0 : s - R, hi = (s + R > SEQ - 1) ? SEQ - 1 : s + R;
    const float inv = 1.0f / (float)(hi - lo + 1);
    u32x4 w; w.x = pg8::cvt_pk_bf16(a[0] * inv - bf_lo(c.x), a[1] * inv - bf_hi(c.x)); w.y = pg8::cvt_pk_bf16(a[2] * inv - bf_lo(c.y), a[3] * inv - bf_hi(c.y));
    w.z = pg8::cvt_pk_bf16(a[4] * inv - bf_lo(c.z), a[5] * inv - bf_hi(c.z)); w.w = pg8::cvt_pk_bf16(a[6] * inv - bf_lo(c.w), a[7] * inv - bf_hi(c.w));
    *(u32x4*)(orow + g * 128 + c16 * 8) = w;
}
__device__ __forceinline__ void pool_load(u32x4 (&v)[6], const bf16_t* Q, int ti, int tid) {
    const int b = ti >> 6, s0 = (ti & 63) * 32;
#pragma unroll
    for (int k = 0; k < 6; ++k) { const int id = tid + 512 * k, row = id >> 6, c = id & 63, s = s0 - 8 + row;
        v[k] = (s >= 0 && s < SEQ) ? *(const u32x4*)(Q + ((size_t)(b * SEQ + s)) * 512 + c * 8) : (u32x4){0u, 0u, 0u, 0u}; }
}
__device__ __forceinline__ int pool_tile_of(int tt) { return (tt & 7) * 128 + (tt >> 3); }
__device__ __forceinline__ void pool_phase(const bf16_t* Q, bf16_t* YC, LAS unsigned char* lds, int G, int c) {
    const int tid = tid_opaque(), lane = tid & 63, wid = tid >> 6;
    const int ntiles = NTOK / 32;
    u32x4 v[6];
    if (c < ntiles) pool_load(v, Q, pool_tile_of(c), tid);
    for (int tt = c; tt < ntiles; tt += G) {
        const int ti = pool_tile_of(tt);
#pragma unroll
        for (int k = 0; k < 6; ++k) *(LAS u32x4*)(lds + (size_t)(tid + 512 * k) * 16) = v[k];
        __syncthreads();
        if (tt + G < ntiles) pool_load(v, Q, pool_tile_of(tt + G), tid);
        const int b = ti >> 6, s0 = (ti & 63) * 32, tl = wid * 4 + (lane >> 4), c16 = lane & 15, s = s0 + tl;
        bf16_t* orow = YC + ((size_t)(b * SEQ + s)) * 1024 + 512;
        pool_group<1>(lds, tl, s, 0, c16, orow); pool_group<2>(lds, tl, s, 1, c16, orow); pool_group<4>(lds, tl, s, 2, c16, orow); pool_group<8>(lds, tl, s, 3, c16, orow);
        __syncthreads();
    }
}

#define XB_TMO      128
#define XB_XCNT(j)  (256  + 64 * (j))
#define XB_XSUB(j)  (1280 + 64 * (j))
#define XB_XGEN(j)  (2304 + 64 * (j))
#define XB_TOP      3328
#define XB_TOPGEN   3392
#define XCD_BAR_WORDS 3456
#define XB_SPIN_CAP (1u << 22)
__device__ __forceinline__ unsigned xb_ld(unsigned* p)              { return __hip_atomic_load(p, __ATOMIC_RELAXED, __HIP_MEMORY_SCOPE_AGENT); }
__device__ __forceinline__ unsigned xb_add(unsigned* p, unsigned v) { return __hip_atomic_fetch_add(p, v, __ATOMIC_RELAXED, __HIP_MEMORY_SCOPE_AGENT); }
__device__ __forceinline__ unsigned xb_xcc_id() { return (unsigned)__builtin_amdgcn_s_getreg((3 << 11) | 20) & 0xFu; }
#define XB_SPIN(cond, bar) do { unsigned _sp = 0; while (cond) { __builtin_amdgcn_s_sleep(1); \
    if ((++_sp & 255u) == 0u) { if (xb_ld(&(bar)[XB_TMO])) break; if (_sp > XB_SPIN_CAP) { atomicAdd(&(bar)[XB_TMO], 1u); break; } } } } while (0)
struct XcdBarrier { unsigned* bar; unsigned x; volatile LAS unsigned* st; };
__device__ __forceinline__ XcdBarrier xcd_barrier_post(unsigned* bar, volatile LAS unsigned* st) {
    XcdBarrier b; b.bar = bar; b.x = xb_xcc_id(); b.st = st;
    if (threadIdx.x == 0) (void)xb_add(&bar[XB_XCNT(b.x)], 1u);
    return b;
}
__device__ __forceinline__ void xcd_barrier_complete(unsigned* bar, unsigned x, unsigned& nloc, unsigned& nx) {
    const unsigned G = gridDim.x * gridDim.y * gridDim.z;
    unsigned sum, cnt, mine, sp = 0u;
    for (;;) {
        sum = 0u; cnt = 0u; mine = 0u;
#pragma unroll
        for (unsigned j = 0; j < 16; ++j) { const unsigned c = xb_ld(&bar[XB_XCNT(j)]); sum += c; cnt += (c > 0u) ? 1u : 0u; mine = (j == x) ? c : mine; }
        if (sum == G) break;
        __builtin_amdgcn_s_sleep(1);
        if ((++sp & 255u) == 0u) { if (xb_ld(&bar[XB_TMO])) break; if (sp > XB_SPIN_CAP) { atomicAdd(&bar[XB_TMO], 1u); break; } }
    }
    nloc = mine > 0u ? mine : 1u; nx = cnt > 0u ? cnt : 1u;
}
__device__ __forceinline__ unsigned xcd_census_uniform(unsigned* bar) {
    if (gridDim.x != 256u) return 0u;
    unsigned ok = 1u;
#pragma unroll
    for (unsigned j = 0; j < 16; ++j) { const unsigned c = xb_ld(&bar[XB_XCNT(j)]); ok &= (j < 8u) ? (c == 32u) : (c == 0u); }
    return ok;
}
__device__ __forceinline__ void xcd_barrier(const XcdBarrier& b) {
    asm volatile("s_waitcnt vmcnt(0)" ::: "memory");
    __syncthreads();
    if (threadIdx.x == 0) {
        unsigned* bar = b.bar;
        __builtin_amdgcn_s_waitcnt(0);
        unsigned nloc = b.st[0], nx = b.st[1];
        if (nloc == 0u) { xcd_barrier_complete(bar, b.x, nloc, nx); b.st[0] = nloc; b.st[1] = nx; b.st[3] = xcd_census_uniform(bar); }
        const unsigned old = xb_add(&bar[XB_XSUB(b.x)], 1u);
        const unsigned gen = old / nloc;
        if (old + 1u == (gen + 1u) * nloc) {
            __builtin_amdgcn_fence(__ATOMIC_RELEASE, "agent");
            asm volatile("s_waitcnt vmcnt(0)" ::: "memory");
            const unsigned og = xb_add(&bar[XB_TOP], 1u);
            const unsigned tg = og / nx;
            if (og + 1u == (tg + 1u) * nx) xb_add(&bar[XB_TOPGEN], 1u);
            else XB_SPIN(xb_ld(&bar[XB_TOPGEN]) == tg, bar);
            __builtin_amdgcn_fence(__ATOMIC_ACQUIRE, "agent");
            xb_add(&bar[XB_XGEN(b.x)], 1u);
            asm volatile("s_waitcnt vmcnt(0)" ::: "memory");
        } else {
            XB_SPIN(xb_ld(&bar[XB_XGEN(b.x)]) == gen, bar);
            __builtin_amdgcn_fence(__ATOMIC_ACQUIRE, "agent");
            asm volatile("s_waitcnt vmcnt(0)" ::: "memory");
        }
    }
    __syncthreads();
}

#define XB_LSUB(j)  (3520 + 64 * (j))
#define XB_LGEN(j)  (4544 + 64 * (j))
__device__ __forceinline__ void xcd_local_barrier(const XcdBarrier& b) {
    asm volatile("s_waitcnt vmcnt(0)" ::: "memory");
    __syncthreads();
    if (threadIdx.x == 0) {
        unsigned* bar = b.bar;
        __builtin_amdgcn_s_waitcnt(0);
        const unsigned old = xb_add(&bar[XB_LSUB(b.x)], 1u);
        const unsigned gen = old / 32u;
        if (old + 1u == (gen + 1u) * 32u) xb_add(&bar[XB_LGEN(b.x)], 1u);
        else { unsigned sp = 0u; while (xb_ld(&bar[XB_LGEN(b.x)]) == gen) { if (++sp > (1u << 24)) { atomicAdd(&bar[XB_TMO], 1u); break; } } }
        __builtin_amdgcn_fence(__ATOMIC_ACQUIRE, "agent");
        asm volatile("s_waitcnt vmcnt(0)" ::: "memory");
    }
    __syncthreads();
}

constexpr int NPHASES = 2 + NL * 10;
__global__ void __launch_bounds__(NTHREADS, 2) fwd_kernel(Params p) {
    extern __shared__ __attribute__((aligned(16))) unsigned char lds_raw[];
    LAS unsigned char* lds = (LAS unsigned char*)lds_raw;
    cg::grid_group grid = cg::this_grid();
    const int G = gridDim.x;
    volatile LAS unsigned* bst = (volatile LAS unsigned*)(lds + LDS_STAGE);
    if (threadIdx.x == 0) { bst[0] = 0u; bst[1] = 0u; bst[2] = 0u; bst[3] = 0u; }
    __syncthreads();
    XcdBarrier xbar; xbar.bar = (unsigned*)(p.ws + OFF_BAR); xbar.x = xb_xcc_id(); xbar.st = bst;
    if (threadIdx.x == 0) bst[2] = xb_add(&xbar.bar[XB_XCNT(xbar.x)], 1u);
    int vc = (int)blockIdx.x; bool local = false;
    bf16_t* WGU = (bf16_t*)(p.ws + OFF_WGU); bf16_t* WD = (bf16_t*)(p.ws + OFF_WD); bf16_t* WA = (bf16_t*)(p.ws + OFF_WA); bf16_t* WB = (bf16_t*)(p.ws + OFF_WB);
    bf16_t* WO = (bf16_t*)(p.ws + OFF_WO); bf16_t* TM = (bf16_t*)(p.ws + OFF_TM); bf16_t* H = (bf16_t*)(p.ws + OFF_H); bf16_t* Y = (bf16_t*)(p.ws + OFF_Y);
    bf16_t* HID = (bf16_t*)(p.ws + OFF_HID); bf16_t* PT = (bf16_t*)(p.ws + OFF_PT); bf16_t* Q = (bf16_t*)(p.ws + OFF_Q); bf16_t* YC = (bf16_t*)(p.ws + OFF_YCAT);
    bf16_t* HF = (bf16_t*)(p.ws + OFF_HF); float* NYQ = (float*)(p.ws + OFF_NYQ);

    for (int ph = p.ph_lo; ph < p.ph_hi; ++ph) {
        if (ph > p.ph_lo) {
            if (p.ph_hi < 0) grid.sync();
            else if (local && ph > 2) xcd_local_barrier(xbar);
            else xcd_barrier(xbar);
            if (XCD_LOCAL && ph == 2 && p.ph_lo == 0) { local = (__builtin_amdgcn_readfirstlane((int)bst[3]) != 0);
                if (local) { vc = __builtin_amdgcn_readfirstlane((int)bst[2]) * 8 + (int)xbar.x;
                    unsigned char* slice = p.ws + OFF_HID + (size_t)xbar.x * ((size_t)4096 * FF * 2);
                    PT = (bf16_t*)(slice - (size_t)xbar.x * ((size_t)4 << 20));
                    Q = (bf16_t*)(slice + ((size_t)4 << 20) - (size_t)xbar.x * ((size_t)4 << 20));
                    YC = (bf16_t*)(slice + ((size_t)8 << 20) - (size_t)xbar.x * ((size_t)8 << 20)); HF = YC;
                    if (STAGGER_TICKS > 0) { const unsigned long long t0 = __builtin_amdgcn_s_memrealtime(), dl = (unsigned long long)xbar.x * STAGGER_TICKS;
                        while (__builtin_amdgcn_s_memrealtime() - t0 < dl) __builtin_amdgcn_s_sleep(8); } } }
        }
        if (ph == 0) {
            for (int rep = 0; rep < PREP_REPS; ++rep) {
            transpose_phase(p, lds, G);
            tm_phase(p, G);
            mcs_phase(p, lds, G);
            }
            norm_phase(nullptr, p.in[0], nullptr, H, nullptr, nullptr, p.in[1], 0.f, G, (int)blockIdx.x);
            continue;
        }
        if (ph == 1) { for (int rep = 0; rep < FOLD_REPS; ++rep) fold_phase(p, lds, G); continue; }
        const int l = (ph - 2) / 10, s = (ph - 2) % 10;
        if (s == 0 || s == 7) {
            const int f = (s == 7);
            pg8::Gemm g{H, WGU + (size_t)(l * 2 + f) * 5632 * 1024, NTOK, 5632, 1024, 0};
            pg8::Order S; S.init(NTOK, 5632, G, vc, 0, G1_WGM);
            pg8::EpiSwiGLU E{HID, 0};
            for (int rep = 0; rep < GEMM_REPS; ++rep) { E.dry = (rep > 0 && p.ph_lo >= 0); pg8::gemm_phase<pg8::EpiSwiGLU, pg8::Order, true, true>(lds, g, S, E); }
        } else if (s == 2 || s == 6 || s == 9) {
            const float* gpost = (s == 2 ? p.in[5] : s == 6 ? p.in[12] : p.in[17]) + (size_t)l * DM;
            const float* gpre = (s == 2 ? p.in[6] + (size_t)l * DM : s == 6 ? p.in[13] + (size_t)l * DM : p.in[1] + (size_t)(l + 1) * DM);
            const bool fin = (s == 9 && l == NL - 1);
            norm_phase(Y, (l == 0 && s == 2) ? p.in[0] : p.out, p.out, fin ? nullptr : H, s == 2 ? HF : nullptr, gpost, gpre, s == 6 ? 1.0f : 0.5f, G, vc);
        } else {
            const int nsub = (s == 3) ? 2 : 1;
            if (s == 3) nyq_phase(WA + (size_t)l * 1024 * 1024, H, NYQ, G, vc);
            for (int sub = 0; sub < nsub; ++sub) {
                pg8::Gemm g; pg8::Order S; pg8::EpiMap E;
                if (s == 1 || s == 8) { const int f = (s == 8); g = pg8::Gemm{HID, WD + (size_t)(l * 2 + f) * 1024 * 2816, NTOK, 1024, 2816, 1}; S.init(NTOK, 1024, G, vc, 0); E = pg8::EpiMap{Y, 1024, 0, 0, nullptr}; }
                else if (s == 3 && sub == 0) { g = pg8::Gemm{WA + (size_t)l * 1024 * 1024, HF, 1024, NTOK, 1024, 0}; S.init(1024, NTOK, G, vc, 2); E = pg8::EpiMap{PT, 2048, 1, 0, nullptr}; }
                else if (s == 3) { g = pg8::Gemm{H, WB + (size_t)l * 512 * 1024, NTOK, 512, 1024, 0}; S.init(NTOK, 512, G, vc, 0); E = pg8::EpiMap{Q, 512, 0, 0, nullptr}; }
                else if (s == 4) { g = pg8::Gemm{TM, PT, 2048, 8192, 2048, 0}; S.init(2048, 8192, G, vc, 1); E = pg8::EpiMap{YC, 1024, 2, 0, NYQ}; }
                else { g = pg8::Gemm{YC, WO + (size_t)l * 1024 * 1024, NTOK, 1024, 1024, 0}; S.init(NTOK, 1024, G, vc, 0); E = pg8::EpiMap{Y, 1024, 0, 0, nullptr}; }
                for (int rep = 0; rep < GEMM_REPS; ++rep) { E.dry = (rep > 0 && p.ph_lo >= 0); pg8::gemm_phase<pg8::EpiMap, pg8::Order, true, true>(lds, g, S, E); }
            }
            if (s == 4) for (int rep = 0; rep < POOL_REPS; ++rep) pool_phase(Q, YC, lds, G, vc);
        }
    }
}

extern "C" void kernel_launch(void* const* d_in, const int* in_sizes, int n_in, void* d_out, int out_size, void* d_ws, size_t ws_size, hipStream_t stream) {
    static int grid = 0;
    if (grid == 0) {
        if (n_in != 18 || out_size != NTOK * DM || ws_size < WS_END) { fprintf(stderr, "kernel_launch: unexpected shapes (n_in %d out %d ws %zu need %zu)\n", n_in, out_size, ws_size, (size_t)WS_END); grid = -1; return; }
        int dev = 0, cus = 0, per_cu = 0;
        hipGetDevice(&dev); hipDeviceGetAttribute(&cus, hipDeviceAttributeMultiprocessorCount, dev);
        if (hipFuncSetAttribute((const void*)fwd_kernel, hipFuncAttributeMaxDynamicSharedMemorySize, LDS_BYTES) != hipSuccess) { fprintf(stderr, "kernel_launch: hipFuncSetAttribute failed\n"); grid = -1; return; }
        if (hipOccupancyMaxActiveBlocksPerMultiprocessor(&per_cu, (const void*)fwd_kernel, NTHREADS, LDS_BYTES) != hipSuccess || per_cu < 1) { fprintf(stderr, "kernel_launch: occupancy query says %d\n", per_cu); per_cu = 1; }
        (void)hipGetLastError();
        grid = cus * per_cu;
        fprintf(stderr, "kernel_launch: grid %d (cus %d x %d)\n", grid, cus, per_cu);
    }
    if (grid < 0) return;
    if (hipMemsetAsync((char*)d_ws + OFF_BAR, 0, SZ_BAR, stream) != hipSuccess) { fprintf(stderr, "kernel_launch: memset failed\n"); return; }
    Params p{};
    for (int i = 0; i < 18; ++i) p.in[i] = (const float*)d_in[i];
    p.out = (float*)d_out; p.ws = (unsigned char*)d_ws;
#if MULTI_LAUNCH
    for (int ph = 0; ph < NPHASES; ++ph) { p.ph_lo = ph; p.ph_hi = ph + 1; hipLaunchKernelGGL(fwd_kernel, dim3(grid), dim3(NTHREADS), LDS_BYTES, stream, p); }
#else
    p.ph_lo = 0; p.ph_hi = NPHASES;
    void* args[] = {&p};
    hipError_t e = hipLaunchCooperativeKernel((const void*)fwd_kernel, dim3(grid), dim3(NTHREADS), args, LDS_BYTES, stream);
    if (e != hipSuccess) fprintf(stderr, "kernel_launch: cooperative launch failed: %s (grid %d)\n", hipGetErrorString(e), grid);
#endif
}
```

```cpp
#include <hip/hip_runtime.h>
#include <hip/hip_cooperative_groups.h>
#include <cstdio>
#include <cstdint>
namespace cg = cooperative_groups;

#ifndef GEMM_REPS
#define GEMM_REPS 1
#endif
#ifndef NORM_REPS
#define NORM_REPS 1
#endif
#ifndef POOL_REPS
#define POOL_REPS 1
#endif
#ifndef FOLD_REPS
#define FOLD_REPS 1
#endif
#ifndef G1_WGM
#define G1_WGM 4
#endif
#ifndef XCD_LOCAL
#define XCD_LOCAL 1
#endif
#ifndef STAGGER_TICKS
#define STAGGER_TICKS 0
#endif
#ifndef PREP_REPS
#define PREP_REPS 1
#endif
#ifndef MULTI_LAUNCH
#define MULTI_LAUNCH 0
#endif

#define LAS __attribute__((address_space(3)))
typedef unsigned short bf16_t;
typedef short bf16x8 __attribute__((ext_vector_type(8)));
typedef float f32x4 __attribute__((ext_vector_type(4)));
typedef unsigned u32x4 __attribute__((ext_vector_type(4)));
typedef unsigned u32x2 __attribute__((ext_vector_type(2)));

__device__ __forceinline__ int tid_opaque() { int t; asm volatile("v_mov_b32 %0, %1" : "=v"(t) : "v"(threadIdx.x)); return t; }

constexpr int NTOK = 32768, DM = 1024, FF = 2816, NL = 4, SEQ = 2048, NB = 16;
constexpr float EPS = 1e-6f;
constexpr int NTHREADS = 512;
constexpr int LDS_STAGE = 131072;
constexpr int LDS_BYTES = LDS_STAGE + 16;

constexpr size_t SZ_WGU = (size_t)NL * 2 * 5632 * 1024 * 2;
constexpr size_t SZ_WD = (size_t)NL * 2 * 1024 * 2816 * 2;
constexpr size_t SZ_WA = (size_t)NL * 1024 * 1024 * 2;
constexpr size_t SZ_WB = (size_t)NL * 512 * 1024 * 2;
constexpr size_t SZ_WO = (size_t)NL * 1024 * 1024 * 2;
constexpr size_t SZ_TM = (size_t)2048 * 2048 * 2;
constexpr size_t SZ_MCS = (size_t)NL * 4 * 128 * 256 * 4;
constexpr size_t SZ_H = (size_t)NTOK * 1024 * 2;
constexpr size_t SZ_Y = (size_t)NTOK * 1024 * 2;
constexpr size_t SZ_HID = (size_t)NTOK * 2816 * 2;
constexpr size_t OFF_WGU = 0;
constexpr size_t OFF_WD = OFF_WGU + SZ_WGU;
constexpr size_t OFF_WA = OFF_WD + SZ_WD;
constexpr size_t OFF_WB = OFF_WA + SZ_WA;
constexpr size_t OFF_WO = OFF_WB + SZ_WB;
constexpr size_t OFF_TM = OFF_WO + SZ_WO;
constexpr size_t OFF_MCS = OFF_TM + SZ_TM;
constexpr size_t OFF_H = OFF_MCS + SZ_MCS;
constexpr size_t OFF_Y = OFF_H + SZ_H;
constexpr size_t OFF_HID = OFF_Y + SZ_Y;
constexpr size_t OFF_PT = OFF_HID;
constexpr size_t SZ_PT = (size_t)NB * 512 * 2048 * 2;
constexpr size_t OFF_Q = OFF_PT + SZ_PT;
constexpr size_t SZ_Q = (size_t)NTOK * 512 * 2;
constexpr size_t OFF_YCAT = OFF_Q + SZ_Q;
constexpr size_t SZ_YCAT = (size_t)NTOK * 1024 * 2;
constexpr size_t OFF_HF = OFF_YCAT;
constexpr size_t SZ_HF = (size_t)2 * NB * 1024 * 1024 * 2;
constexpr size_t OFF_BAR = OFF_HID + SZ_HID;
constexpr size_t SZ_BAR = 32768;
constexpr size_t OFF_NYQ = OFF_BAR + SZ_BAR;
constexpr size_t SZ_NYQ = (size_t)NB * 512 * 4;
constexpr size_t WS_END = OFF_NYQ + SZ_NYQ;
static_assert(OFF_YCAT + SZ_YCAT <= OFF_BAR && OFF_HF + SZ_HF <= OFF_BAR, "alias region");

struct Params { const float* in[18]; float* out; unsigned char* ws; int ph_lo, ph_hi; };

namespace pg8 {
constexpr int BM = 256, BK = 64, HALF = 128, HTB = HALF * BK * 2, STAGE_BYTES = 8 * HTB, NXCD = 8, WGM = 8;
__host__ __device__ __forceinline__ int lds_byte(int r, int c) { const int st = (r >> 4) * 2 + (c >> 5), rr = r & 15, cc = c & 31, ob = rr * 64 + cc * 2; return st * 1024 + (ob ^ (((ob >> 9) & 1) << 5)); }
__host__ __device__ __forceinline__ void stage_rc(int b, int& R, int& C) { const int st = b / 1024, sb = b % 1024, swz = sb ^ (((sb >> 9) & 1) << 5); R = (st >> 1) * 16 + swz / 64; C = (st & 1) * 32 + (swz % 64) / 2; }
__host__ __device__ __forceinline__ int perm32(int rho) { const int n = rho >> 4, i = rho & 15; return 8 * (i >> 2) + 4 * n + (i & 3); }

struct Unit { int pm, pn; };
struct Gemm { const bf16_t* A; const bf16_t* Bt; int M, N, K; int ablk; };

struct Order {
    int nM, nN, nwg, G, c, mode, wgm;
    __device__ void init(int M, int N, int G_, int c_, int mode_, int wgm_ = WGM) { nM = M / BM; nN = N / BM; nwg = (mode_ == 2) ? 256 : nM * nN; G = G_; c = c_; mode = mode_; wgm = wgm_; }
    __device__ bool next(int i, Unit& u) const {
        const long L = (long)i * G + c; if (L >= nwg) return false;
        if (mode == 1) { const int xcd = (int)L & 7, j = (int)L >> 3; const int b = 2 * xcd + (j >> 4); u.pn = b * 2 + ((j >> 3) & 1); u.pm = j & 7; return true; }
        if (mode == 2) { const int x = (int)L & 7, i = (int)L >> 3, part = i >> 4, b = 2 * x + ((i >> 3) & 1); u.pm = part * 2 + (i & 1); u.pn = b * 8 + part * 4 + ((i >> 1) & 3); return true; }
        int wgid = (int)L; { const int q = nwg / NXCD, r = nwg % NXCD, xcd = wgid % NXCD, off = wgid / NXCD; wgid = (xcd < r ? xcd * (q + 1) : r * (q + 1) + (xcd - r) * q) + off; }
        const int nig = wgm * nN, gid = wgid / nig, fm = gid * wgm, gsz = (nM - fm) < wgm ? (nM - fm) : wgm;
        u.pm = fm + ((wgid % nig) % gsz); u.pn = (wgid % nig) / gsz; return true;
    }
    __device__ __forceinline__ void a_ready(const Unit&) const {}
    __device__ __forceinline__ void done(const Unit&) const {}
};

__device__ __forceinline__ unsigned cvt_pk_bf16(float lo, float hi) { unsigned r; asm volatile("v_cvt_pk_bf16_f32 %0, %1, %2" : "=v"(r) : "v"(lo), "v"(hi)); return r; }

struct EpiMap {
    static constexpr bool PERM = true, AFTER_DRAIN = false;
    bf16_t* O; int ldc; int mode; int dry; const float* nyq;
    __device__ __forceinline__ void operator()(const f32x4 (&acc)[2][2][4][2], const Unit& u, int wr, int wc, int fr, int fq) const {
        if (dry) return;
        size_t tb; int ld = ldc;
        if (mode == 0) tb = (size_t)u.pm * 256 * (size_t)ldc + (size_t)u.pn * 256;
        else if (mode == 1) { tb = ((size_t)((u.pn >> 3) * 512 + (u.pm & 1) * 256)) * 2048 + (size_t)((u.pm >> 1) * 1024 + (u.pn & 3) * 256); ld = 2048; }
        else { tb = ((size_t)((u.pn >> 1) * 2048 + u.pm * 256)) * 1024 + (size_t)((u.pn & 1) * 256); ld = 1024; }
        bf16_t* base = O + tb + (size_t)(wr * 64 + fr) * ld + wc * 32 + 8 * fq;
#pragma unroll
        for (int ai = 0; ai < 2; ++ai)
#pragma unroll
            for (int m = 0; m < 4; ++m) { bf16_t* rowp = base + (size_t)(ai * HALF + m * 16) * ld;
#pragma unroll
                for (int bj = 0; bj < 2; ++bj) { f32x4 v0 = acc[ai][bj][m][0], v1 = acc[ai][bj][m][1];
                    if (mode == 2) { const float* q = nyq + (u.pn >> 1) * 512 + (u.pn & 1) * 256 + bj * HALF + wc * 32 + 8 * fq; const float sg = (fr & 1) ? (-1.0f / 512.0f) : (1.0f / 512.0f);
                        v0 += *(const f32x4*)q * sg; v1 += *(const f32x4*)(q + 4) * sg; }
                    u32x4 w; w.x = cvt_pk_bf16(v0[0], v0[1]); w.y = cvt_pk_bf16(v0[2], v0[3]); w.z = cvt_pk_bf16(v1[0], v1[1]); w.w = cvt_pk_bf16(v1[2], v1[3]);
                    *(u32x4*)(rowp + bj * HALF) = w; } }
    }
};
__device__ __forceinline__ float silu_mul(float a, float b) { return (a * b) * __builtin_amdgcn_rcpf(1.0f + __builtin_amdgcn_exp2f(-a)); }
struct EpiSwiGLU {
    static constexpr bool PERM = true, AFTER_DRAIN = false;
    bf16_t* O; int dry;
    __device__ __forceinline__ void operator()(const f32x4 (&acc)[2][2][4][2], const Unit& u, int wr, int wc, int fr, int fq) const {
        if (dry) return;
        bf16_t* base = O + ((size_t)(u.pm * (FF / 64) + u.pn * 2 + (wc >> 1)) * 256 + wr * 64 + fr) * 64 + (wc & 1) * 32 + 8 * fq;
#pragma unroll
        for (int ai = 0; ai < 2; ++ai)
#pragma unroll
            for (int m = 0; m < 4; ++m) { bf16_t* rowp = base + (size_t)(ai * HALF + m * 16) * 64;
                const f32x4 g0 = acc[ai][0][m][0], g1 = acc[ai][0][m][1], u0 = acc[ai][1][m][0], u1 = acc[ai][1][m][1];
                u32x4 w; w.x = cvt_pk_bf16(silu_mul(g0[0], u0[0]), silu_mul(g0[1], u0[1])); w.y = cvt_pk_bf16(silu_mul(g0[2], u0[2]), silu_mul(g0[3], u0[3]));
                w.z = cvt_pk_bf16(silu_mul(g1[0], u1[0]), silu_mul(g1[1], u1[1])); w.w = cvt_pk_bf16(silu_mul(g1[2], u1[2]), silu_mul(g1[3], u1[3]));
                *(u32x4*)rowp = w; }
    }
};

template <class Epi, class Sched, bool ALIGN_EPI = false, bool SP2 = false>
__device__ __forceinline__ void gemm_phase(LAS unsigned char* lds, const Gemm g, const Sched& S, const Epi& E) {
    const int tid = tid_opaque(), wid = __builtin_amdgcn_readfirstlane(tid >> 6), lane = tid & 63, wr = wid >> 2, wc = wid & 3, fr = lane & 15, fq = lane >> 4;
    const int K = g.K, nt = K / BK;
    unsigned voffA[2], voffB[2];
#pragma unroll
    for (int i = 0; i < 2; ++i) { int R, C; stage_rc(tid * 16 + i * 8192, R, C); const int Rb = Epi::PERM ? ((R & ~31) + perm32(R & 31)) : R;
        voffA[i] = (unsigned)(R * (g.ablk ? BK : K) + C) * 2u; voffB[i] = (unsigned)(Rb * K + C) * 2u; }
    const size_t kstep = (size_t)(BK * 2);
    const size_t hstep = (size_t)HALF * K * 2;
    const size_t tstep = 2 * hstep;
    const size_t kstepA = g.ablk ? (size_t)BM * BK * 2 : kstep, hstepA = g.ablk ? (size_t)HALF * BK * 2 : hstep;
    const unsigned ldsw = (unsigned)wid * 1024u;
    const int aoff = lds_byte(wr * 64 + fr, fq * 8), boff = lds_byte(wc * 32 + fr, fq * 8);
#define PG8_SA(b, h) (((b) * 2 + (h)) * HTB)
#define PG8_SB(b, h) ((4 + (b) * 2 + (h)) * HTB)
#define PG8_STAGE(bufoff, gbase, voff) do { _Pragma("unroll") for (int _i = 0; _i < 2; ++_i) \
        __builtin_amdgcn_global_load_lds((const unsigned*)((const char*)(gbase) + (voff)[_i]), (LAS unsigned*)(lds + (bufoff) + ldsw + _i * 8192), 16, 0, 0); } while (0)
#define PG8_LDA(dst, b, h) do { _Pragma("unroll") for (int m = 0; m < 4; ++m) _Pragma("unroll") for (int k = 0; k < 2; ++k) dst[m][k] = *(const LAS bf16x8*)(lds + PG8_SA(b, h) + aoff + m * 2048 + k * 1024); } while (0)
#define PG8_LDB(dst, b, h) do { _Pragma("unroll") for (int n = 0; n < 2; ++n) _Pragma("unroll") for (int k = 0; k < 2; ++k) dst[n][k] = *(const LAS bf16x8*)(lds + PG8_SB(b, h) + boff + n * 2048 + k * 1024); } while (0)
#define PG8_MMA(ai, bj, At, Bt) do { __builtin_amdgcn_s_setprio(1); _Pragma("unroll") for (int m = 0; m < 4; ++m) _Pragma("unroll") for (int n = 0; n < 2; ++n) _Pragma("unroll") for (int k = 0; k < 2; ++k) \
        acc[ai][bj][m][n] = __builtin_amdgcn_mfma_f32_16x16x32_bf16(Bt[n][k], At[m][k], acc[ai][bj][m][n], 0, 0, 0); __builtin_amdgcn_s_setprio(0); } while (0)
#define PG8_WAIT_V(n) asm volatile("s_waitcnt vmcnt(" #n ")" ::: "memory")
#define PG8_WAIT_L(n) asm volatile("s_waitcnt lgkmcnt(" #n ")" ::: "memory")
#define PG8_BAR __builtin_amdgcn_s_barrier()
#define PG8_SCHED __builtin_amdgcn_sched_barrier(0)
    Unit cur, nxt; int ui = 0;
    if (!S.next(0, cur)) return;
    f32x4 acc[2][2][4][2];
#pragma unroll
    for (int a = 0; a < 2; ++a)
#pragma unroll
        for (int b = 0; b < 2; ++b)
#pragma unroll
            for (int m = 0; m < 4; ++m)
#pragma unroll
                for (int n = 0; n < 2; ++n) acc[a][b][m][n] = (f32x4){0.f, 0.f, 0.f, 0.f};
    bf16x8 At[4][2], B0[2][2], B1[2][2];
    const char* cA = (const char*)g.A + (size_t)cur.pm * tstep; const char* cB = (const char*)g.Bt + (size_t)cur.pn * tstep;
    S.a_ready(cur);
    if constexpr (SP2) {
        PG8_STAGE(PG8_SB(0, 0), cB, voffB); PG8_STAGE(PG8_SB(0, 1), cB + hstep, voffB); PG8_STAGE(PG8_SA(0, 0), cA, voffA); PG8_STAGE(PG8_SA(0, 1), cA + hstepA, voffA);
        if (wr == 1) PG8_BAR;
        PG8_WAIT_V(2); PG8_BAR;
        PG8_STAGE(PG8_SB(1, 0), cB + kstep, voffB); PG8_STAGE(PG8_SA(1, 0), cA + kstepA, voffA); PG8_STAGE(PG8_SB(1, 1), cB + hstep + kstep, voffB);
        PG8_WAIT_V(6); PG8_BAR;
    } else {
        PG8_STAGE(PG8_SB(0, 0), cB, voffB); PG8_STAGE(PG8_SA(0, 0), cA, voffA); PG8_STAGE(PG8_SB(0, 1), cB + hstep, voffB); PG8_STAGE(PG8_SA(0, 1), cA + hstep, voffA);
        if (wr == 1) PG8_BAR;
        PG8_WAIT_V(4); PG8_BAR;
        PG8_STAGE(PG8_SB(1, 0), cB + kstep, voffB); PG8_STAGE(PG8_SA(1, 0), cA + kstep, voffA); PG8_STAGE(PG8_SB(1, 1), cB + hstep + kstep, voffB);
        PG8_WAIT_V(6); PG8_BAR;
    }
    for (;;) {
        const bool has_next = S.next(ui + 1, nxt);
        const char* nA = has_next ? (const char*)g.A + (size_t)nxt.pm * tstep : cA + (size_t)(nt - 2) * kstepA; const char* nB = has_next ? (const char*)g.Bt + (size_t)nxt.pn * tstep : cB + (size_t)(nt - 2) * kstep;
        for (int t = 0; t < nt; t += 2) {
            const bool last = (t == nt - 2);
            const char* a1 = cA + (size_t)(t + 1) * kstepA;
            const char* a2 = last ? nA : cA + (size_t)(t + 2) * kstepA; const char* b2 = last ? nB : cB + (size_t)(t + 2) * kstep;
            const char* a3 = a2 + kstepA; const char* b3 = b2 + kstep;
            if (last && has_next) S.a_ready(nxt);
            if constexpr (SP2) {
            PG8_LDB(B0, 0, 0); PG8_LDB(B1, 0, 1); PG8_SCHED; PG8_LDA(At, 0, 0); PG8_STAGE(PG8_SA(1, 1), a1 + hstepA, voffA);
            PG8_WAIT_V(8); PG8_WAIT_L(0); PG8_BAR; PG8_MMA(0, 0, At, B0); PG8_MMA(0, 1, At, B1); PG8_BAR; PG8_SCHED;
            PG8_LDA(At, 0, 1); PG8_STAGE(PG8_SB(0, 0), b2, voffB); PG8_STAGE(PG8_SB(0, 1), b2 + hstep, voffB); PG8_STAGE(PG8_SA(0, 0), a2, voffA);
            PG8_WAIT_V(8); PG8_WAIT_L(0); PG8_BAR; PG8_MMA(1, 0, At, B0); PG8_MMA(1, 1, At, B1); PG8_BAR; PG8_SCHED;
            PG8_LDB(B0, 1, 0); PG8_LDB(B1, 1, 1); PG8_SCHED; PG8_LDA(At, 1, 0); PG8_STAGE(PG8_SA(0, 1), a2 + hstepA, voffA);
            PG8_WAIT_V(8); PG8_WAIT_L(0); PG8_BAR; PG8_MMA(0, 0, At, B0); PG8_MMA(0, 1, At, B1); PG8_BAR; PG8_SCHED;
            PG8_LDA(At, 1, 1); PG8_STAGE(PG8_SB(1, 0), b3, voffB); PG8_STAGE(PG8_SB(1, 1), b3 + hstep, voffB); PG8_STAGE(PG8_SA(1, 0), a3, voffA);
            PG8_WAIT_V(8); PG8_WAIT_L(0); PG8_BAR; PG8_MMA(1, 0, At, B0); PG8_MMA(1, 1, At, B1); PG8_BAR; PG8_SCHED;
            } else {
            PG8_LDB(B0, 0, 0); PG8_SCHED; PG8_LDA(At, 0, 0); PG8_STAGE(PG8_SA(1, 1), a1 + hstep, voffA);
            PG8_WAIT_L(8); PG8_BAR; PG8_WAIT_L(0); PG8_MMA(0, 0, At, B0); PG8_BAR; PG8_SCHED;
            PG8_LDB(B1, 0, 1); PG8_STAGE(PG8_SB(0, 0), b2, voffB);
            PG8_BAR; PG8_WAIT_L(0); PG8_MMA(0, 1, At, B1); PG8_BAR;
            PG8_LDA(At, 0, 1); PG8_STAGE(PG8_SA(0, 0), a2, voffA);
            PG8_BAR; PG8_WAIT_L(0); PG8_MMA(1, 0, At, B0); PG8_BAR; PG8_SCHED;
            PG8_STAGE(PG8_SB(0, 1), b2 + hstep, voffB);
            PG8_WAIT_V(6); PG8_BAR; PG8_MMA(1, 1, At, B1); PG8_BAR;
            PG8_LDB(B0, 1, 0); PG8_SCHED; PG8_LDA(At, 1, 0); PG8_STAGE(PG8_SA(0, 1), a2 + hstep, voffA);
            PG8_WAIT_L(8); PG8_BAR; PG8_WAIT_L(0); PG8_MMA(0, 0, At, B0); PG8_BAR; PG8_SCHED;
            PG8_LDB(B1, 1, 1); PG8_STAGE(PG8_SB(1, 0), b3, voffB);
            PG8_BAR; PG8_WAIT_L(0); PG8_MMA(0, 1, At, B1); PG8_BAR;
            PG8_LDA(At, 1, 1); PG8_STAGE(PG8_SA(1, 0), a3, voffA);
            PG8_BAR; PG8_WAIT_L(0); PG8_MMA(1, 0, At, B0); PG8_BAR; PG8_SCHED;
            PG8_STAGE(PG8_SB(1, 1), b3 + hstep, voffB);
            PG8_WAIT_V(6); PG8_BAR; PG8_MMA(1, 1, At, B1); PG8_BAR;
            }
        }
        if constexpr (ALIGN_EPI) { if (wr == 0) PG8_BAR; }
        if constexpr (!Epi::AFTER_DRAIN) { E(acc, cur, wr, wc, fr, fq); S.done(cur); }
        if (!has_next) break;
#pragma unroll
        for (int a = 0; a < 2; ++a)
#pragma unroll
            for (int b = 0; b < 2; ++b)
#pragma unroll
                for (int m = 0; m < 4; ++m)
#pragma unroll
                    for (int n = 0; n < 2; ++n) acc[a][b][m][n] = (f32x4){0.f, 0.f, 0.f, 0.f};
        cur = nxt; cA = nA; cB = nB; ++ui;
        if constexpr (ALIGN_EPI) { if (wr == 1) PG8_BAR; }
    }
    PG8_WAIT_V(0);
    if constexpr (!ALIGN_EPI) { if (wr == 0) PG8_BAR; }
    PG8_BAR;
#undef PG8_SA
#undef PG8_SB
#undef PG8_STAGE
#undef PG8_LDA
#undef PG8_LDB
#undef PG8_MMA
#undef PG8_WAIT_V
#undef PG8_WAIT_L
#undef PG8_BAR
#undef PG8_SCHED
}
}

__device__ __forceinline__ float wave_sum(float v) {
    v += __shfl_xor(v, 32); v += __shfl_xor(v, 16); v += __shfl_xor(v, 8); v += __shfl_xor(v, 4); v += __shfl_xor(v, 2); v += __shfl_xor(v, 1); return v;
}
__device__ __forceinline__ float bf_lo(unsigned u) { return __uint_as_float(u << 16); }
__device__ __forceinline__ float bf_hi(unsigned u) { return __uint_as_float(u & 0xffff0000u); }

struct NormRow { f32x4 x[4]; u32x4 y[2]; };
__device__ __forceinline__ NormRow norm_load_row(const bf16_t* y, const float* xin, bool xin24, int row, int lane, bool has_y) {
    NormRow r; const float* xr = xin + (size_t)row * DM; const unsigned char* xb = (const unsigned char*)xr;
    if (xin24) {
        const u32x4 h0 = __builtin_nontemporal_load((const u32x4*)(xb + lane * 16)), h1 = __builtin_nontemporal_load((const u32x4*)(xb + 1024 + lane * 16));
        const u32x2 l0 = __builtin_nontemporal_load((const u32x2*)(xb + 2048 + lane * 8)), l1 = __builtin_nontemporal_load((const u32x2*)(xb + 2560 + lane * 8));
        r.x[0] = (f32x4){__uint_as_float(h0.x), __uint_as_float(h0.y), __uint_as_float(h0.z), __uint_as_float(h0.w)};
        r.x[1] = (f32x4){__uint_as_float(h1.x), __uint_as_float(h1.y), __uint_as_float(h1.z), __uint_as_float(h1.w)};
        r.x[2] = (f32x4){__uint_as_float(l0.x), __uint_as_float(l0.y), __uint_as_float(l1.x), __uint_as_float(l1.y)}; r.x[3] = (f32x4){0.f, 0.f, 0.f, 0.f};
    } else {
        r.x[0] = __builtin_nontemporal_load((const f32x4*)(xr + lane * 8)); r.x[1] = __builtin_nontemporal_load((const f32x4*)(xr + lane * 8 + 4));
        r.x[2] = __builtin_nontemporal_load((const f32x4*)(xr + 512 + lane * 8)); r.x[3] = __builtin_nontemporal_load((const f32x4*)(xr + 512 + lane * 8 + 4));
    }
    if (has_y) { r.y[0] = __builtin_nontemporal_load((const u32x4*)(y + (size_t)row * DM + lane * 8)); r.y[1] = __builtin_nontemporal_load((const u32x4*)(y + (size_t)row * DM + 512 + lane * 8)); }
    else { r.y[0] = (u32x4){0u, 0u, 0u, 0u}; r.y[1] = (u32x4){0u, 0u, 0u, 0u}; }
    return r;
}
__device__ __forceinline__ f32x4 x24_dec4(unsigned wa, unsigned wb, unsigned l) {
    return (f32x4){__uint_as_float((wa << 16) | ((l & 0xffu) << 8)), __uint_as_float((wa & 0xffff0000u) | (l & 0xff00u)), __uint_as_float((wb << 16) | ((l >> 8) & 0xff00u)), __uint_as_float((wb & 0xffff0000u) | ((l >> 16) & 0xff00u))};
}
__device__ __forceinline__ unsigned x24_lo4(f32x4 v, unsigned& ha, unsigned& hb) {
    const unsigned b0 = __float_as_uint(v[0]) + 0x80u, b1 = __float_as_uint(v[1]) + 0x80u, b2 = __float_as_uint(v[2]) + 0x80u, b3 = __float_as_uint(v[3]) + 0x80u;
    ha = (b0 >> 16) | (b1 & 0xffff0000u); hb = (b2 >> 16) | (b3 & 0xffff0000u);
    return ((b0 >> 8) & 0xffu) | (b1 & 0xff00u) | ((b2 << 8) & 0xff0000u) | ((b3 << 16) & 0xff000000u);
}
__device__ __forceinline__ f32x4 bf4(unsigned a, unsigned b) { return (f32x4){bf_lo(a), bf_hi(a), bf_lo(b), bf_hi(b)}; }
__device__ __forceinline__ u32x4 pack8(f32x4 a, f32x4 b) { u32x4 w; w.x = pg8::cvt_pk_bf16(a[0], a[1]); w.y = pg8::cvt_pk_bf16(a[2], a[3]); w.z = pg8::cvt_pk_bf16(b[0], b[1]); w.w = pg8::cvt_pk_bf16(b[2], b[3]); return w; }
__device__ __forceinline__ float sumsq4(f32x4 v) { return (v[0] * v[0] + v[1] * v[1]) + (v[2] * v[2] + v[3] * v[3]); }
__device__ __forceinline__ void norm_rows_of(int qq, int& bk, int& r0, int& r1) {
    const int x = (qq >> 3) & 7, pl = ((qq >> 6) << 3) | (qq & 7), b = 2 * x + (pl >> 10), k = pl & 1023;
    bk = b * 1024 + k; r0 = b * SEQ + k; r1 = b * SEQ + (k == 0 ? SEQ / 2 : SEQ - k);
}
struct NormOut { f32x4 a, b, c, d; float rs; };
__device__ __forceinline__ NormOut norm_one(const NormRow& r, float* xout, int row, int lane, f32x4 g0, f32x4 g1, f32x4 g2, f32x4 g3, float coef, bool xin24, bool xout24, bool has_y, bool has_h) {
    const unsigned w0 = __float_as_uint(r.x[0][0]), w1 = __float_as_uint(r.x[0][1]), w2 = __float_as_uint(r.x[0][2]), w3 = __float_as_uint(r.x[0][3]);
    const unsigned w4 = __float_as_uint(r.x[1][0]), w5 = __float_as_uint(r.x[1][1]), w6 = __float_as_uint(r.x[1][2]), w7 = __float_as_uint(r.x[1][3]);
    const unsigned la = __float_as_uint(r.x[2][0]), lb = __float_as_uint(r.x[2][1]), lc = __float_as_uint(r.x[2][2]), ld = __float_as_uint(r.x[2][3]);
    NormOut o;
    o.a = xin24 ? x24_dec4(w0, w1, la) : r.x[0]; o.b = xin24 ? x24_dec4(w2, w3, lb) : r.x[1]; o.c = xin24 ? x24_dec4(w4, w5, lc) : r.x[2]; o.d = xin24 ? x24_dec4(w6, w7, ld) : r.x[3];
    if (has_y) {
        const f32x4 v0 = bf4(r.y[0].x, r.y[0].y), v1 = bf4(r.y[0].z, r.y[0].w), v2 = bf4(r.y[1].x, r.y[1].y), v3 = bf4(r.y[1].z, r.y[1].w);
        float s = (sumsq4(v0) + sumsq4(v1)) + (sumsq4(v2) + sumsq4(v3));
        s = wave_sum(s);
        const float cy = coef * rsqrtf(s * (1.0f / DM) + EPS);
        o.a += v0 * g0 * cy; o.b += v1 * g1 * cy; o.c += v2 * g2 * cy; o.d += v3 * g3 * cy;
    }
    if (xout) {
        float* xr = xout + (size_t)row * DM; unsigned char* xb = (unsigned char*)xr;
        if (xout24) {
            unsigned h0, h1, h2, h3, h4, h5, h6, h7; u32x2 l0, l1;
            l0.x = x24_lo4(o.a, h0, h1); l0.y = x24_lo4(o.b, h2, h3); l1.x = x24_lo4(o.c, h4, h5); l1.y = x24_lo4(o.d, h6, h7);
            __builtin_nontemporal_store((u32x4){h0, h1, h2, h3}, (u32x4*)(xb + lane * 16)); __builtin_nontemporal_store((u32x4){h4, h5, h6, h7}, (u32x4*)(xb + 1024 + lane * 16));
            __builtin_nontemporal_store(l0, (u32x2*)(xb + 2048 + lane * 8)); __builtin_nontemporal_store(l1, (u32x2*)(xb + 2560 + lane * 8));
        } else {
            __builtin_nontemporal_store(o.a, (f32x4*)(xr + lane * 8)); __builtin_nontemporal_store(o.b, (f32x4*)(xr + lane * 8 + 4));
            __builtin_nontemporal_store(o.c, (f32x4*)(xr + 512 + lane * 8)); __builtin_nontemporal_store(o.d, (f32x4*)(xr + 512 + lane * 8 + 4));
        }
    }
    o.rs = 0.f;
    if (has_h) { float s = (sumsq4(o.a) + sumsq4(o.b)) + (sumsq4(o.c) + sumsq4(o.d)); s = wave_sum(s); o.rs = rsqrtf(s * (1.0f / DM) + EPS); }
    return o;
}
__device__ __forceinline__ void norm_phase(const bf16_t* y, const float* xin, float* xout, bf16_t* h, bf16_t* hf, const float* gpost, const float* gpre, float coef, int G, int c, bool xin24, bool xout24) {
    const int tid = tid_opaque(); const int lane = tid & 63, wid = tid >> 6;
    const int gw = c * 8 + wid, nw = G * 8;
    const bool has_y = (y != nullptr), has_h = (h != nullptr), fold = (hf != nullptr);
    const f32x4 z4 = (f32x4){0.f, 0.f, 0.f, 0.f};
    const f32x4 gp0 = has_y ? *(const f32x4*)(gpost + lane * 8) : z4, gp1 = has_y ? *(const f32x4*)(gpost + lane * 8 + 4) : z4, gp2 = has_y ? *(const f32x4*)(gpost + 512 + lane * 8) : z4, gp3 = has_y ? *(const f32x4*)(gpost + 512 + lane * 8 + 4) : z4;
    const f32x4 gq0 = has_h ? *(const f32x4*)(gpre + lane * 8) : z4, gq1 = has_h ? *(const f32x4*)(gpre + lane * 8 + 4) : z4, gq2 = has_h ? *(const f32x4*)(gpre + 512 + lane * 8) : z4, gq3 = has_h ? *(const f32x4*)(gpre + 512 + lane * 8 + 4) : z4;
    for (int q = gw; q < NTOK / 2; q += nw) {
        int r0, r1, bk; norm_rows_of(q, bk, r0, r1);
        const NormRow ra = norm_load_row(y, xin, xin24, r0, lane, has_y), rb = norm_load_row(y, xin, xin24, r1, lane, has_y);
        const NormOut A = norm_one(ra, xout, r0, lane, gp0, gp1, gp2, gp3, coef, xin24, xout24, has_y, has_h);
        const NormOut B = norm_one(rb, xout, r1, lane, gp0, gp1, gp2, gp3, coef, xin24, xout24, has_y, has_h);
        if (has_h) {
            const float fs = ((bk & 1023) == 0) ? 0.f : 1.f;
            const size_t oe = ((size_t)(bk >> 10) * 2048 + (bk & 1023)) * DM, oo = oe + (size_t)1024 * DM;
            const f32x4 a0 = A.a * gq0 * A.rs, a1 = A.b * gq1 * A.rs, a2 = A.c * gq2 * A.rs, a3 = A.d * gq3 * A.rs;
            const f32x4 b0 = B.a * gq0 * B.rs, b1 = B.b * gq1 * B.rs, b2 = B.c * gq2 * B.rs, b3 = B.d * gq3 * B.rs;
            *(u32x4*)(h + (size_t)r0 * DM + lane * 8) = pack8(a0, a1); *(u32x4*)(h + (size_t)r0 * DM + 512 + lane * 8) = pack8(a2, a3);
            *(u32x4*)(h + (size_t)r1 * DM + lane * 8) = pack8(b0, b1); *(u32x4*)(h + (size_t)r1 * DM + 512 + lane * 8) = pack8(b2, b3);
            if (fold) {
                *(u32x4*)(hf + oe + lane * 8) = pack8(a0 + b0 * fs, a1 + b1 * fs); *(u32x4*)(hf + oe + 512 + lane * 8) = pack8(a2 + b2 * fs, a3 + b3 * fs);
                *(u32x4*)(hf + oo + lane * 8) = pack8((a0 - b0) * fs, (a1 - b1) * fs); *(u32x4*)(hf + oo + 512 + lane * 8) = pack8((a2 - b2) * fs, (a3 - b3) * fs);
            }
        }
    }
}

struct TrJob { const float* src; bf16_t* dst; int N, tn, ldd, kind, t0; };
__device__ __forceinline__ TrJob tr_decode(const Params& p, int R) {
    constexpr int TPL = 4480;
    bf16_t* WGU = (bf16_t*)(p.ws + OFF_WGU); bf16_t* WD = (bf16_t*)(p.ws + OFF_WD); bf16_t* WO = (bf16_t*)(p.ws + OFF_WO);
    const int ti0 = R * 4, l = ti0 / TPL, r = ti0 % TPL; int m = r / 704; if (m > 6) m = 6;
    TrJob j; j.t0 = r - m * 704;
    if (m == 0) { j.src = p.in[2] + (size_t)l * 1024 * 2816; j.N = 2816; j.tn = 44; j.dst = WGU + (size_t)(l * 2 + 0) * 5632 * 1024; j.ldd = 1024; j.kind = 0; }
    else if (m == 1) { j.src = p.in[3] + (size_t)l * 1024 * 2816; j.N = 2816; j.tn = 44; j.dst = WGU + (size_t)(l * 2 + 0) * 5632 * 1024; j.ldd = 1024; j.kind = 1; }
    else if (m == 2) { j.src = p.in[4] + (size_t)l * 2816 * 1024; j.N = 1024; j.tn = 16; j.dst = WD + (size_t)(l * 2 + 0) * 1024 * 2816; j.ldd = 2816; j.kind = 2; }
    else if (m == 3) { j.src = p.in[14] + (size_t)l * 1024 * 2816; j.N = 2816; j.tn = 44; j.dst = WGU + (size_t)(l * 2 + 1) * 5632 * 1024; j.ldd = 1024; j.kind = 0; }
    else if (m == 4) { j.src = p.in[15] + (size_t)l * 1024 * 2816; j.N = 2816; j.tn = 44; j.dst = WGU + (size_t)(l * 2 + 1) * 5632 * 1024; j.ldd = 1024; j.kind = 1; }
    else if (m == 5) { j.src = p.in[16] + (size_t)l * 2816 * 1024; j.N = 1024; j.tn = 16; j.dst = WD + (size_t)(l * 2 + 1) * 1024 * 2816; j.ldd = 2816; j.kind = 2; }
    else { j.src = p.in[11] + (size_t)l * 1024 * 1024; j.N = 1024; j.tn = 16; j.dst = WO + (size_t)l * 1024 * 1024; j.ldd = 1024; j.kind = 2; }
    return j;
}
__device__ __forceinline__ void tr_load(f32x4 (&v)[4][2], const TrJob& j, int tid) {
#pragma unroll
    for (int q = 0; q < 4; ++q) { const int t = j.t0 + q, kt = t / j.tn, ntile = t - kt * j.tn;
#pragma unroll
        for (int i = 0; i < 2; ++i) v[q][i] = __builtin_nontemporal_load((const f32x4*)(j.src + (size_t)(kt * 64 + (tid >> 4) + 32 * i) * j.N + ntile * 64 + (tid & 15) * 4)); }
}
__device__ __forceinline__ void transpose_phase(const Params& p, LAS unsigned char* lds, int G) {
    LAS float* T = (LAS float*)lds;
    const int tid = tid_opaque();
    const int nrounds = NL * 4480 / 4;
    f32x4 v[4][2];
    TrJob cur, nxt;
    if ((int)blockIdx.x < nrounds) { cur = tr_decode(p, blockIdx.x); tr_load(v, cur, tid); }
    for (int R = blockIdx.x; R < nrounds; R += G) {
#pragma unroll
        for (int q = 0; q < 4; ++q)
#pragma unroll
            for (int i = 0; i < 2; ++i) { LAS float* d = T + q * 4160 + ((tid >> 4) + 32 * i) * 65 + (tid & 15) * 4; d[0] = v[q][i][0]; d[1] = v[q][i][1]; d[2] = v[q][i][2]; d[3] = v[q][i][3]; }
        __syncthreads();
        nxt = cur;
        if (R + G < nrounds) { nxt = tr_decode(p, R + G); tr_load(v, nxt, tid); }
#pragma unroll
        for (int q = 0; q < 4; ++q) { const int t = cur.t0 + q, kt = t / cur.tn, ntile = t - kt * cur.tn;
            const int nl = tid >> 3, k8 = (tid & 7) * 8; const int n = ntile * 64 + nl;
            const int drow = (cur.kind == 2) ? n : ((n >> 7) * 256 + (n & 127) + (cur.kind == 1 ? 128 : 0));
            const LAS float* s = T + q * 4160 + k8 * 65 + nl;
            const float sc = (cur.kind == 0) ? 1.4426950408889634f : (cur.kind == 1) ? 0.6931471805599453f : 1.0f;
            u32x4 w; w.x = pg8::cvt_pk_bf16(s[0] * sc, s[65] * sc); w.y = pg8::cvt_pk_bf16(s[130] * sc, s[195] * sc); w.z = pg8::cvt_pk_bf16(s[260] * sc, s[325] * sc); w.w = pg8::cvt_pk_bf16(s[390] * sc, s[455] * sc);
            *(u32x4*)(cur.dst + (size_t)drow * cur.ldd + kt * 64 + k8) = w; }
        __syncthreads();
        cur = nxt;
    }
}

__device__ __forceinline__ void tm_phase(const Params& p, int G) {
    bf16_t* TM = (bf16_t*)(p.ws + OFF_TM);
    const int total = 2048 * 2048 / 8; const int tid = tid_opaque();
    for (int e = blockIdx.x * NTHREADS + tid; e < total; e += G * NTHREADS) {
        const int s = e >> 8, k0 = (e & 255) * 8; float v[8];
#pragma unroll
        for (int j = 0; j < 8; ++j) { const int k = k0 + j, kk = k & 1023; const int ph = (s * kk) & 2047; const float a = (float)ph * (1.0f / 1024.0f);
            v[j] = (k < 1024) ? cospif(a) * (1.0f / 512.0f) : -sinpif(a) * (1.0f / 512.0f); }
        u32x4 w; w.x = pg8::cvt_pk_bf16(v[0], v[1]); w.y = pg8::cvt_pk_bf16(v[2], v[3]); w.z = pg8::cvt_pk_bf16(v[4], v[5]); w.w = pg8::cvt_pk_bf16(v[6], v[7]);
        *(u32x4*)(TM + (size_t)e * 8) = w;
    }
}

__device__ __forceinline__ void nyq_phase(const bf16_t* WA, const bf16_t* H, float* nyq, int G, int c) {
    const int tid = tid_opaque(), lane = tid & 63, wid = tid >> 6;
    for (int tt = c * 8 + wid; tt < NB * 512; tt += G * 8) {
        const int x = (tt >> 3) & 7, tl = ((tt >> 6) << 3) | (tt & 7), b = 2 * x + (tl >> 9), n = tl & 511, t = b * 512 + n;
        const bf16_t* w = WA + (size_t)n * 1024 + lane * 8; const bf16_t* h = H + ((size_t)b * SEQ + 1024) * 1024 + lane * 8;
        float acc = 0.f;
#pragma unroll
        for (int j = 0; j < 2; ++j) { const u32x4 a = *(const u32x4*)(w + 512 * j), c = *(const u32x4*)(h + 512 * j);
            acc += bf_lo(a.x) * bf_lo(c.x) + bf_hi(a.x) * bf_hi(c.x) + bf_lo(a.y) * bf_lo(c.y) + bf_hi(a.y) * bf_hi(c.y) + bf_lo(a.z) * bf_lo(c.z) + bf_hi(a.z) * bf_hi(c.z) + bf_lo(a.w) * bf_lo(c.w) + bf_hi(a.w) * bf_hi(c.w); }
        acc = wave_sum(acc);
        if (lane == 0) nyq[t] = acc;
    }
}

__device__ __forceinline__ void mcs_phase(const Params& p, LAS unsigned char* lds, int G) {
    LAS float* tab = (LAS float*)lds;
    const int tid = tid_opaque();
    if (tid < 128) { const float a = (float)tid * (1.0f / 64.0f); tab[tid] = cospif(a); tab[128 + tid] = sinpif(a); }
    __syncthreads();
    float* MCS = (float*)(p.ws + OFF_MCS); const float* fw = p.in[8];
    const int total = NL * 4 * 128 * 256;
    for (int e = blockIdx.x * NTHREADS + tid; e < total; e += G * NTHREADS) {
        const int col = e & 255, c = (e >> 8) & 127, lh = e >> 15; const int part = col >> 7, d = col & 127;
        const float* w = fw + (size_t)lh * 128 * 128 + d; float acc = 0.f;
        for (int k = 0; k < 128; ++k) acc += tab[part * 128 + ((c * k) & 127)] * w[(size_t)k * 128];
        MCS[e] = acc;
    }
    __syncthreads();
}

__device__ __forceinline__ void fold_phase(const Params& p, LAS unsigned char* lds, int G) {
    LAS float* Wt = (LAS float*)lds;
    LAS float* Mt = (LAS float*)(lds + 128 * 132 * 4);
    const int tid = tid_opaque();
    const float* MCS = (const float*)(p.ws + OFF_MCS);
    bf16_t* WA = (bf16_t*)(p.ws + OFF_WA); bf16_t* WB = (bf16_t*)(p.ws + OFF_WB);
    const int nitems = NL * 24 * 8;
    for (int it = blockIdx.x; it < nitems; it += G) {
        const int kb = it & 7, ch = (it >> 3) % 24, l = (it >> 3) / 24;
        const float* win = p.in[7] + (size_t)l * 1024 * 1024;
        const float* msrc; int ldm, wcol; bf16_t* dst; const float* scl = nullptr;
        if (ch < 16) { const int h = ch >> 2, cc = ch & 3; msrc = MCS + (size_t)(l * 4 + h) * 128 * 256 + cc * 64; ldm = 256; wcol = h * 128;
            dst = WA + ((size_t)l * 1024 + (cc >> 1) * 512 + h * 128 + (cc & 1) * 64) * 1024; }
        else { const int g = (ch - 16) >> 1, d0 = ((ch - 16) & 1) * 64; msrc = p.in[9] + (size_t)(l * 4 + g) * 128 * 128 + d0; ldm = 128; wcol = 512 + g * 128;
            dst = WB + ((size_t)l * 512 + g * 128 + d0) * 1024; scl = p.in[10] + (size_t)l * 512 + g * 128 + d0; }
#pragma unroll
        for (int i = 0; i < 8; ++i) { const int kk = (tid >> 5) + 16 * i, c4 = (tid & 31) * 4;
            *(LAS f32x4*)(Wt + kk * 132 + c4) = *(const f32x4*)(win + (size_t)(kb * 128 + kk) * 1024 + wcol + c4); }
#pragma unroll
        for (int i = 0; i < 4; ++i) { const int c = (tid >> 4) + 32 * i, j4 = (tid & 15) * 4;
            f32x4 mv = *(const f32x4*)(msrc + (size_t)c * ldm + j4);
            if (scl) mv *= *(const f32x4*)(scl + j4);
            *(LAS f32x4*)(Mt + c * 64 + j4) = mv; }
        __syncthreads();
        const int j4 = (tid & 15) * 4, k4 = (tid >> 4) * 4;
        f32x4 acc[4];
#pragma unroll
        for (int q = 0; q < 4; ++q) acc[q] = (f32x4){0.f, 0.f, 0.f, 0.f};
        for (int c4 = 0; c4 < 32; ++c4) {
            const f32x4 m0 = *(const LAS f32x4*)(Mt + (c4 * 4 + 0) * 64 + j4), m1 = *(const LAS f32x4*)(Mt + (c4 * 4 + 1) * 64 + j4);
            const f32x4 m2 = *(const LAS f32x4*)(Mt + (c4 * 4 + 2) * 64 + j4), m3 = *(const LAS f32x4*)(Mt + (c4 * 4 + 3) * 64 + j4);
#pragma unroll
            for (int q = 0; q < 4; ++q) { const f32x4 w = *(const LAS f32x4*)(Wt + (k4 + q) * 132 + c4 * 4); acc[q] += (m0 * w[0] + m1 * w[1]) + (m2 * w[2] + m3 * w[3]); }
        }
#pragma unroll
        for (int jj = 0; jj < 4; ++jj) { u32x2 w; w.x = pg8::cvt_pk_bf16(acc[0][jj], acc[1][jj]); w.y = pg8::cvt_pk_bf16(acc[2][jj], acc[3][jj]);
            *(u32x2*)(dst + (size_t)(j4 + jj) * 1024 + kb * 128 + k4) = w; }
        __syncthreads();
    }
}

template <int R> __device__ __forceinline__ void pool_group(const LAS unsigned char* tile, int tl, int s, int g, int c16, bf16_t* orow) {
    float a[8];
#pragma unroll
    for (int q = 0; q < 8; ++q) a[q] = 0.f;
    const LAS unsigned char* base = tile + (tl + 8 - R) * 1024 + g * 256 + c16 * 16;
    u32x4 c;
#pragma unroll
    for (int j = 0; j <= 2 * R; ++j) { const u32x4 v = *(const LAS u32x4*)(base + j * 1024); if (j == R) c = v;
        a[0] += bf_lo(v.x); a[1] += bf_hi(v.x); a[2] += bf_lo(v.y); a[3] += bf_hi(v.y); a[4] += bf_lo(v.z); a[5] += bf_hi(v.z); a[6] += bf_lo(v.w); a[7] += bf_hi(v.w); }
    const int lo = (s - R < 0) ? 0 : s - R, hi = (s + R > SEQ - 1) ? SEQ - 1 : s + R;
    const float inv = 1.0f / (float)(hi - lo + 1);
    u32x4 w; w.x = pg8::cvt_pk_bf16(a[0] * inv - bf_lo(c.x), a[1] * inv - bf_hi(c.x)); w.y = pg8::cvt_pk_bf16(a[2] * inv - bf_lo(c.y), a[3] * inv - bf_hi(c.y));
    w.z = pg8::cvt_pk_bf16(a[4] * inv - bf_lo(c.z), a[5] * inv - bf_hi(c.z)); w.w = pg8::cvt_pk_bf16(a[6] * inv - bf_lo(c.w), a[7] * inv - bf_hi(c.w));
    *(u32x4*)(orow + g * 128 + c16 * 8) = w;
}
__device__ __forceinline__ void pool_load(u32x4 (&v)[6], const bf16_t* Q, int ti, int tid) {
    const int b = ti >> 6, s0 = (ti & 63) * 32;
#pragma unroll
    for (int k = 0; k < 6; ++k) { const int id = tid + 512 * k, row = id >> 6, c = id & 63, s = s0 - 8 + row;
        v[k] = (s >= 0 && s < SEQ) ? *(const u32x4*)(Q + ((size_t)(b * SEQ + s)) * 512 + c * 8) : (u32x4){0u, 0u, 0u, 0u}; }
}
__device__ __forceinline__ int pool_tile_of(int tt) { return (tt & 7) * 128 + (tt >> 3); }
__device__ __forceinline__ void pool_phase(const bf16_t* Q, bf16_t* YC, LAS unsigned char* lds, int G, int c) {
    const int tid = tid_opaque(), lane = tid & 63, wid = tid >> 6;
    const int ntiles = NTOK / 32;
    u32x4 v[6];
    if (c < ntiles) pool_load(v, Q, pool_tile_of(c), tid);
    for (int tt = c; tt < ntiles; tt += G) {
        const int ti = pool_tile_of(tt);
#pragma unroll
        for (int k = 0; k < 6; ++k) *(LAS u32x4*)(lds + (size_t)(tid + 512 * k) * 16) = v[k];
        __syncthreads();
        if (tt + G < ntiles) pool_load(v, Q, pool_tile_of(tt + G), tid);
        const int b = ti >> 6, s0 = (ti & 63) * 32, tl = wid * 4 + (lane >> 4), c16 = lane & 15, s = s0 + tl;
        bf16_t* orow = YC + ((size_t)(b * SEQ + s)) * 1024 + 512;
        pool_group<1>(lds, tl, s, 0, c16, orow); pool_group<2>(lds, tl, s, 1, c16, orow); pool_group<4>(lds, tl, s, 2, c16, orow); pool_group<8>(lds, tl, s, 3, c16, orow);
        __syncthreads();
    }
}

#define XB_TMO      128
#define XB_XCNT(j)  (256  + 64 * (j))
#define XB_XSUB(j)  (1280 + 64 * (j))
#define XB_XGEN(j)  (2304 + 64 * (j))
#define XB_TOP      3328
#define XB_TOPGEN   3392
#define XCD_BAR_WORDS 3456
#define XB_SPIN_CAP (1u << 22)
__device__ __forceinline__ unsigned xb_ld(unsigned* p)              { return __hip_atomic_load(p, __ATOMIC_RELAXED, __HIP_MEMORY_SCOPE_AGENT); }
__device__ __forceinline__ unsigned xb_add(unsigned* p, unsigned v) { return __hip_atomic_fetch_add(p, v, __ATOMIC_RELAXED, __HIP_MEMORY_SCOPE_AGENT); }
__device__ __forceinline__ unsigned xb_xcc_id() { return (unsigned)__builtin_amdgcn_s_getreg((3 << 11) | 20) & 0xFu; }
#define XB_SPIN(cond, bar) do { unsigned _sp = 0; while (cond) { __builtin_amdgcn_s_sleep(1); \
    if ((++_sp & 255u) == 0u) { if (xb_ld(&(bar)[XB_TMO])) break; if (_sp > XB_SPIN_CAP) { atomicAdd(&(bar)[XB_TMO], 1u); break; } } } } while (0)
struct XcdBarrier { unsigned* bar; unsigned x; volatile LAS unsigned* st; };
__device__ __forceinline__ XcdBarrier xcd_barrier_post(unsigned* bar, volatile LAS unsigned* st) {
    XcdBarrier b; b.bar = bar; b.x = xb_xcc_id(); b.st = st;
    if (threadIdx.x == 0) (void)xb_add(&bar[XB_XCNT(b.x)], 1u);
    return b;
}
__device__ __forceinline__ void xcd_barrier_complete(unsigned* bar, unsigned x, unsigned& nloc, unsigned& nx) {
    const unsigned G = gridDim.x * gridDim.y * gridDim.z;
    unsigned sum, cnt, mine, sp = 0u;
    for (;;) {
        sum = 0u; cnt = 0u; mine = 0u;
#pragma unroll
        for (unsigned j = 0; j < 16; ++j) { const unsigned c = xb_ld(&bar[XB_XCNT(j)]); sum += c; cnt += (c > 0u) ? 1u : 0u; mine = (j == x) ? c : mine; }
        if (sum == G) break;
        __builtin_amdgcn_s_sleep(1);
        if ((++sp & 255u) == 0u) { if (xb_ld(&bar[XB_TMO])) break; if (sp > XB_SPIN_CAP) { atomicAdd(&bar[XB_TMO], 1u); break; } }
    }
    nloc = mine > 0u ? mine : 1u; nx = cnt > 0u ? cnt : 1u;
}
__device__ __forceinline__ unsigned xcd_census_uniform(unsigned* bar) {
    if (gridDim.x != 256u) return 0u;
    unsigned ok = 1u;
#pragma unroll
    for (unsigned j = 0; j < 16; ++j) { const unsigned c = xb_ld(&bar[XB_XCNT(j)]); ok &= (j < 8u) ? (c == 32u) : (c == 0u); }
    return ok;
}
__device__ __forceinline__ void xcd_barrier(const XcdBarrier& b) {
    asm volatile("s_waitcnt vmcnt(0)" ::: "memory");
    __syncthreads();
    if (threadIdx.x == 0) {
        unsigned* bar = b.bar;
        __builtin_amdgcn_s_waitcnt(0);
        unsigned nloc = b.st[0], nx = b.st[1];
        if (nloc == 0u) { xcd_barrier_complete(bar, b.x, nloc, nx); b.st[0] = nloc; b.st[1] = nx; b.st[3] = xcd_census_uniform(bar); }
        const unsigned old = xb_add(&bar[XB_XSUB(b.x)], 1u);
        const unsigned gen = old / nloc;
        if (old + 1u == (gen + 1u) * nloc) {
            __builtin_amdgcn_fence(__ATOMIC_RELEASE, "agent");
            asm volatile("s_waitcnt vmcnt(0)" ::: "memory");
            const unsigned og = xb_add(&bar[XB_TOP], 1u);
            const unsigned tg = og / nx;
            if (og + 1u == (tg + 1u) * nx) xb_add(&bar[XB_TOPGEN], 1u);
            else XB_SPIN(xb_ld(&bar[XB_TOPGEN]) == tg, bar);
            __builtin_amdgcn_fence(__ATOMIC_ACQUIRE, "agent");
            xb_add(&bar[XB_XGEN(b.x)], 1u);
            asm volatile("s_waitcnt vmcnt(0)" ::: "memory");
        } else {
            XB_SPIN(xb_ld(&bar[XB_XGEN(b.x)]) == gen, bar);
            __builtin_amdgcn_fence(__ATOMIC_ACQUIRE, "agent");
            asm volatile("s_waitcnt vmcnt(0)" ::: "memory");
        }
    }
    __syncthreads();
}

#define XB_LSUB(j)  (3520 + 64 * (j))
#define XB_LGEN(j)  (4544 + 64 * (j))
__device__ __forceinline__ void xcd_local_barrier(const XcdBarrier& b) {
    asm volatile("s_waitcnt vmcnt(0)" ::: "memory");
    __syncthreads();
    if (threadIdx.x == 0) {
        unsigned* bar = b.bar;
        __builtin_amdgcn_s_waitcnt(0);
        const unsigned old = xb_add(&bar[XB_LSUB(b.x)], 1u);
        const unsigned gen = old / 32u;
        if (old + 1u == (gen + 1u) * 32u) xb_add(&bar[XB_LGEN(b.x)], 1u);
        else { unsigned sp = 0u; while (xb_ld(&bar[XB_LGEN(b.x)]) == gen) { if (++sp > (1u << 24)) { atomicAdd(&bar[XB_TMO], 1u); break; } } }
        __builtin_amdgcn_fence(__ATOMIC_ACQUIRE, "agent");
        asm volatile("s_waitcnt vmcnt(0)" ::: "memory");
    }
    __syncthreads();
}

constexpr int NPHASES = 2 + NL * 10;
__global__ void __launch_bounds__(NTHREADS, 2) fwd_kernel(Params p) {
    extern __shared__ __attribute__((aligned(16))) unsigned char lds_raw[];
    LAS unsigned char* lds = (LAS unsigned char*)lds_raw;
    cg::grid_group grid = cg::this_grid();
    const int G = gridDim.x;
    volatile LAS unsigned* bst = (volatile LAS unsigned*)(lds + LDS_STAGE);
    if (threadIdx.x == 0) { bst[0] = 0u; bst[1] = 0u; bst[2] = 0u; bst[3] = 0u; }
    __syncthreads();
    XcdBarrier xbar; xbar.bar = (unsigned*)(p.ws + OFF_BAR); xbar.x = xb_xcc_id(); xbar.st = bst;
    if (threadIdx.x == 0) bst[2] = xb_add(&xbar.bar[XB_XCNT(xbar.x)], 1u);
    int vc = (int)blockIdx.x; bool local = false;
    bf16_t* WGU = (bf16_t*)(p.ws + OFF_WGU); bf16_t* WD = (bf16_t*)(p.ws + OFF_WD); bf16_t* WA = (bf16_t*)(p.ws + OFF_WA); bf16_t* WB = (bf16_t*)(p.ws + OFF_WB);
    bf16_t* WO = (bf16_t*)(p.ws + OFF_WO); bf16_t* TM = (bf16_t*)(p.ws + OFF_TM); bf16_t* H = (bf16_t*)(p.ws + OFF_H); bf16_t* Y = (bf16_t*)(p.ws + OFF_Y);
    bf16_t* HID = (bf16_t*)(p.ws + OFF_HID); bf16_t* PT = (bf16_t*)(p.ws + OFF_PT); bf16_t* Q = (bf16_t*)(p.ws + OFF_Q); bf16_t* YC = (bf16_t*)(p.ws + OFF_YCAT);
    bf16_t* HF = (bf16_t*)(p.ws + OFF_HF); float* NYQ = (float*)(p.ws + OFF_NYQ);

    for (int ph = p.ph_lo; ph < p.ph_hi; ++ph) {
        if (ph > p.ph_lo) {
            if (p.ph_hi < 0) grid.sync();
            else if (local && ph > 2) xcd_local_barrier(xbar);
            else xcd_barrier(xbar);
            if (XCD_LOCAL && ph == 2 && p.ph_lo == 0) { local = (__builtin_amdgcn_readfirstlane((int)bst[3]) != 0);
                if (local) { vc = __builtin_amdgcn_readfirstlane((int)bst[2]) * 8 + (int)xbar.x;
                    unsigned char* slice = p.ws + OFF_HID + (size_t)xbar.x * ((size_t)4096 * FF * 2);
                    PT = (bf16_t*)(slice - (size_t)xbar.x * ((size_t)4 << 20));
                    Q = (bf16_t*)(slice + ((size_t)4 << 20) - (size_t)xbar.x * ((size_t)4 << 20));
                    YC = (bf16_t*)(slice + ((size_t)8 << 20) - (size_t)xbar.x * ((size_t)8 << 20)); HF = YC;
                    if (STAGGER_TICKS > 0) { const unsigned long long t0 = __builtin_amdgcn_s_memrealtime(), dl = (unsigned long long)xbar.x * STAGGER_TICKS;
                        while (__builtin_amdgcn_s_memrealtime() - t0 < dl) __builtin_amdgcn_s_sleep(8); } } }
        }
        if (ph == 0) {
            for (int rep = 0; rep < PREP_REPS; ++rep) {
            transpose_phase(p, lds, G);
            tm_phase(p, G);
            mcs_phase(p, lds, G);
            }
            norm_phase(nullptr, p.in[0], nullptr, H, nullptr, nullptr, p.in[1], 0.f, G, (int)blockIdx.x, false, false);
            continue;
        }
        if (ph == 1) { for (int rep = 0; rep < FOLD_REPS; ++rep) fold_phase(p, lds, G); continue; }
        const int l = (ph - 2) / 10, s = (ph - 2) % 10;
        if (s == 0 || s == 7) {
            const int f = (s == 7);
            pg8::Gemm g{H, WGU + (size_t)(l * 2 + f) * 5632 * 1024, NTOK, 5632, 1024, 0};
            pg8::Order S; S.init(NTOK, 5632, G, vc, 0, G1_WGM);
            pg8::EpiSwiGLU E{HID, 0};
            for (int rep = 0; rep < GEMM_REPS; ++rep) { E.dry = (rep > 0 && p.ph_lo >= 0); pg8::gemm_phase<pg8::EpiSwiGLU, pg8::Order, true, true>(lds, g, S, E); }
        } else if (s == 2 || s == 6 || s == 9) {
            const float* gpost = (s == 2 ? p.in[5] : s == 6 ? p.in[12] : p.in[17]) + (size_t)l * DM;
            const float* gpre = (s == 2 ? p.in[6] + (size_t)l * DM : s == 6 ? p.in[13] + (size_t)l * DM : p.in[1] + (size_t)(l + 1) * DM);
            const bool fin = (s == 9 && l == NL - 1);
            norm_phase(Y, (l == 0 && s == 2) ? p.in[0] : p.out, p.out, fin ? nullptr : H, s == 2 ? HF : nullptr, gpost, gpre, s == 6 ? 1.0f : 0.5f, G, vc, !(l == 0 && s == 2), !fin);
        } else {
            const int nsub = (s == 3) ? 2 : 1;
            if (s == 3) nyq_phase(WA + (size_t)l * 1024 * 1024, H, NYQ, G, vc);
            for (int sub = 0; sub < nsub; ++sub) {
                pg8::Gemm g; pg8::Order S; pg8::EpiMap E;
                if (s == 1 || s == 8) { const int f = (s == 8); g = pg8::Gemm{HID, WD + (size_t)(l * 2 + f) * 1024 * 2816, NTOK, 1024, 2816, 1}; S.init(NTOK, 1024, G, vc, 0); E = pg8::EpiMap{Y, 1024, 0, 0, nullptr}; }
                else if (s == 3 && sub == 0) { g = pg8::Gemm{WA + (size_t)l * 1024 * 1024, HF, 1024, NTOK, 1024, 0}; S.init(1024, NTOK, G, vc, 2); E = pg8::EpiMap{PT, 2048, 1, 0, nullptr}; }
                else if (s == 3) { g = pg8::Gemm{H, WB + (size_t)l * 512 * 1024, NTOK, 512, 1024, 0}; S.init(NTOK, 512, G, vc, 0); E = pg8::EpiMap{Q, 512, 0, 0, nullptr}; }
                else if (s == 4) { g = pg8::Gemm{TM, PT, 2048, 8192, 2048, 0}; S.init(2048, 8192, G, vc, 1); E = pg8::EpiMap{YC, 1024, 2, 0, NYQ}; }
                else { g = pg8::Gemm{YC, WO + (size_t)l * 1024 * 1024, NTOK, 1024, 1024, 0}; S.init(NTOK, 1024, G, vc, 0); E = pg8::EpiMap{Y, 1024, 0, 0, nullptr}; }
                for (int rep = 0; rep < GEMM_REPS; ++rep) { E.dry = (rep > 0 && p.ph_lo >= 0); pg8::gemm_phase<pg8::EpiMap, pg8::Order, true, true>(lds, g, S, E); }
            }
            if (s == 4) for (int rep = 0; rep < POOL_REPS; ++rep) pool_phase(Q, YC, lds, G, vc);
        }
    }
}

extern "C" void kernel_launch(void* const* d_in, const int* in_sizes, int n_in, void* d_out, int out_size, void* d_ws, size_t ws_size, hipStream_t stream) {
    static int grid = 0;
    if (grid == 0) {
        if (n_in != 18 || out_size != NTOK * DM || ws_size < WS_END) { fprintf(stderr, "kernel_launch: unexpected shapes (n_in %d out %d ws %zu need %zu)\n", n_in, out_size, ws_size, (size_t)WS_END); grid = -1; return; }
        int dev = 0, cus = 0, per_cu = 0;
        hipGetDevice(&dev); hipDeviceGetAttribute(&cus, hipDeviceAttributeMultiprocessorCount, dev);
        if (hipFuncSetAttribute((const void*)fwd_kernel, hipFuncAttributeMaxDynamicSharedMemorySize, LDS_BYTES) != hipSuccess) { fprintf(stderr, "kernel_launch: hipFuncSetAttribute failed\n"); grid = -1; return; }
        if (hipOccupancyMaxActiveBlocksPerMultiprocessor(&per_cu, (const void*)fwd_kernel, NTHREADS, LDS_BYTES) != hipSuccess || per_cu < 1) { fprintf(stderr, "kernel_launch: occupancy query says %d\n", per_cu); per_cu = 1; }
        (void)hipGetLastError();
        grid = cus * per_cu;
        fprintf(stderr, "kernel_launch: grid %d (cus %d x %d)\n", grid, cus, per_cu);
    }
    if (grid < 0) return;
    if (hipMemsetAsync((char*)d_ws + OFF_BAR, 0, SZ_BAR, stream) != hipSuccess) { fprintf(stderr, "kernel_launch: memset failed\n"); return; }
    Params p{};
    for (int i = 0; i < 18; ++i) p.in[i] = (const float*)d_in[i];
    p.out = (float*)d_out; p.ws = (unsigned char*)d_ws;
#if MULTI_LAUNCH
    for (int ph = 0; ph < NPHASES; ++ph) { p.ph_lo = ph; p.ph_hi = ph + 1; hipLaunchKernelGGL(fwd_kernel, dim3(grid), dim3(NTHREADS), LDS_BYTES, stream, p); }
#else
    p.ph_lo = 0; p.ph_hi = NPHASES;
    void* args[] = {&p};
    hipError_t e = hipLaunchCooperativeKernel((const void*)fwd_kernel, dim3(grid), dim3(NTHREADS), args, LDS_BYTES, stream);
    if (e != hipSuccess) fprintf(stderr, "kernel_launch: cooperative launch failed: %s (grid %d)\n", hipGetErrorString(e), grid);
#endif
}
```

```cpp
#include <hip/hip_runtime.h>
#include <hip/hip_cooperative_groups.h>
#include <cstdio>
#include <cstdint>
namespace cg = cooperative_groups;

#ifndef GEMM_REPS
#define GEMM_REPS 1
#endif
#ifndef NORM_REPS
#define NORM_REPS 1
#endif
#ifndef POOL_REPS
#define POOL_REPS 1
#endif
#ifndef FOLD_REPS
#define FOLD_REPS 1
#endif
#ifndef G1_WGM
#define G1_WGM 4
#endif
#ifndef XCD_LOCAL
#define XCD_LOCAL 1
#endif
#ifndef STAGGER_TICKS
#define STAGGER_TICKS 0
#endif
#ifndef PREP_REPS
#define PREP_REPS 1
#endif
#ifndef MULTI_LAUNCH
#define MULTI_LAUNCH 0
#endif

#define LAS __attribute__((address_space(3)))
typedef unsigned short bf16_t;
typedef short bf16x8 __attribute__((ext_vector_type(8)));
typedef float f32x4 __attribute__((ext_vector_type(4)));
typedef unsigned u32x4 __attribute__((ext_vector_type(4)));
typedef unsigned u32x2 __attribute__((ext_vector_type(2)));

__device__ __forceinline__ int tid_opaque() { int t; asm volatile("v_mov_b32 %0, %1" : "=v"(t) : "v"(threadIdx.x)); return t; }

constexpr int NTOK = 32768, DM = 1024, FF = 2816, NL = 4, SEQ = 2048, NB = 16;
constexpr float EPS = 1e-6f;
constexpr int NTHREADS = 512;
constexpr int LDS_STAGE = 131072;
constexpr int LDS_BYTES = LDS_STAGE + 16;

constexpr size_t SZ_WGU = (size_t)NL * 2 * 5632 * 1024 * 2;
constexpr size_t SZ_WD = (size_t)NL * 2 * 1024 * 2816 * 2;
constexpr size_t SZ_WA = (size_t)NL * 1024 * 1024 * 2;
constexpr size_t SZ_WB = (size_t)NL * 512 * 1024 * 2;
constexpr size_t SZ_WO = (size_t)NL * 1024 * 1024 * 2;
constexpr size_t SZ_TM = (size_t)2048 * 2048 * 2;
constexpr size_t SZ_MCS = (size_t)NL * 4 * 128 * 256 * 4;
constexpr size_t SZ_H = (size_t)NTOK * 1024 * 2;
constexpr size_t SZ_Y = (size_t)NTOK * 1024 * 2;
constexpr size_t SZ_HID = (size_t)NTOK * 2816 * 2;
constexpr size_t OFF_WGU = 0;
constexpr size_t OFF_WD = OFF_WGU + SZ_WGU;
constexpr size_t OFF_WA = OFF_WD + SZ_WD;
constexpr size_t OFF_WB = OFF_WA + SZ_WA;
constexpr size_t OFF_WO = OFF_WB + SZ_WB;
constexpr size_t OFF_TM = OFF_WO + SZ_WO;
constexpr size_t OFF_MCS = OFF_TM + SZ_TM;
constexpr size_t OFF_H = OFF_MCS + SZ_MCS;
constexpr size_t OFF_Y = OFF_H + SZ_H;
constexpr size_t OFF_HID = OFF_Y + SZ_Y;
constexpr size_t OFF_PT = OFF_HID;
constexpr size_t SZ_PT = (size_t)NB * 512 * 2048 * 2;
constexpr size_t OFF_Q = OFF_PT + SZ_PT;
constexpr size_t SZ_Q = (size_t)NTOK * 512 * 2;
constexpr size_t OFF_YCAT = OFF_Q + SZ_Q;
constexpr size_t SZ_YCAT = (size_t)NTOK * 1024 * 2;
constexpr size_t OFF_HF = OFF_YCAT;
constexpr size_t SZ_HF = (size_t)2 * NB * 1024 * 1024 * 2;
constexpr size_t OFF_BAR = OFF_HID + SZ_HID;
constexpr size_t SZ_BAR = 32768;
constexpr size_t OFF_NYQ = OFF_BAR + SZ_BAR;
constexpr size_t SZ_NYQ = (size_t)NB * 512 * 4;
constexpr size_t WS_END = OFF_NYQ + SZ_NYQ;
static_assert(OFF_YCAT + SZ_YCAT <= OFF_BAR && OFF_HF + SZ_HF <= OFF_BAR, "alias region");

struct Params { const float* in[18]; float* out; unsigned char* ws; int ph_lo, ph_hi; };

namespace pg8 {
constexpr int BM = 256, BK = 64, HALF = 128, HTB = HALF * BK * 2, STAGE_BYTES = 8 * HTB, NXCD = 8, WGM = 8;
__host__ __device__ __forceinline__ int lds_byte(int r, int c) { const int st = (r >> 4) * 2 + (c >> 5), rr = r & 15, cc = c & 31, ob = rr * 64 + cc * 2; return st * 1024 + (ob ^ (((ob >> 9) & 1) << 5)); }
__host__ __device__ __forceinline__ void stage_rc(int b, int& R, int& C) { const int st = b / 1024, sb = b % 1024, swz = sb ^ (((sb >> 9) & 1) << 5); R = (st >> 1) * 16 + swz / 64; C = (st & 1) * 32 + (swz % 64) / 2; }
__host__ __device__ __forceinline__ int perm32(int rho) { const int n = rho >> 4, i = rho & 15; return 8 * (i >> 2) + 4 * n + (i & 3); }

struct Unit { int pm, pn; };
struct Gemm { const bf16_t* A; const bf16_t* Bt; int M, N, K; int ablk; };

struct Order {
    int nM, nN, nwg, G, c, mode, wgm;
    __device__ void init(int M, int N, int G_, int c_, int mode_, int wgm_ = WGM) { nM = M / BM; nN = N / BM; nwg = (mode_ == 2) ? 256 : nM * nN; G = G_; c = c_; mode = mode_; wgm = wgm_; }
    __device__ bool next(int i, Unit& u) const {
        const long L = (long)i * G + c; if (L >= nwg) return false;
        if (mode == 1) { const int xcd = (int)L & 7, j = (int)L >> 3; const int b = 2 * xcd + (j >> 4); u.pn = b * 2 + ((j >> 3) & 1); u.pm = j & 7; return true; }
        if (mode == 2) { const int x = (int)L & 7, i = (int)L >> 3, part = i >> 4, b = 2 * x + ((i >> 3) & 1); u.pm = part * 2 + (i & 1); u.pn = b * 8 + part * 4 + ((i >> 1) & 3); return true; }
        int wgid = (int)L; { const int q = nwg / NXCD, r = nwg % NXCD, xcd = wgid % NXCD, off = wgid / NXCD; wgid = (xcd < r ? xcd * (q + 1) : r * (q + 1) + (xcd - r) * q) + off; }
        const int nig = wgm * nN, gid = wgid / nig, fm = gid * wgm, gsz = (nM - fm) < wgm ? (nM - fm) : wgm;
        u.pm = fm + ((wgid % nig) % gsz); u.pn = (wgid % nig) / gsz; return true;
    }
    __device__ __forceinline__ void a_ready(const Unit&) const {}
    __device__ __forceinline__ void done(const Unit&) const {}
};

__device__ __forceinline__ unsigned cvt_pk_bf16(float lo, float hi) { unsigned r; asm volatile("v_cvt_pk_bf16_f32 %0, %1, %2" : "=v"(r) : "v"(lo), "v"(hi)); return r; }

struct EpiMap {
    static constexpr bool PERM = true, AFTER_DRAIN = false;
    bf16_t* O; int ldc; int mode; int dry; const float* nyq;
    __device__ __forceinline__ void operator()(const f32x4 (&acc)[2][2][4][2], const Unit& u, int wr, int wc, int fr, int fq) const {
        if (dry) return;
        size_t tb; int ld = ldc;
        if (mode == 0) tb = (size_t)u.pm * 256 * (size_t)ldc + (size_t)u.pn * 256;
        else if (mode == 1) { tb = ((size_t)((u.pn >> 3) * 512 + (u.pm & 1) * 256)) * 2048 + (size_t)((u.pm >> 1) * 1024 + (u.pn & 3) * 256); ld = 2048; }
        else { tb = ((size_t)((u.pn >> 1) * 2048 + u.pm * 256)) * 1024 + (size_t)((u.pn & 1) * 256); ld = 1024; }
        bf16_t* base = O + tb + (size_t)(wr * 64 + fr) * ld + wc * 32 + 8 * fq;
#pragma unroll
        for (int ai = 0; ai < 2; ++ai)
#pragma unroll
            for (int m = 0; m < 4; ++m) { bf16_t* rowp = base + (size_t)(ai * HALF + m * 16) * ld;
#pragma unroll
                for (int bj = 0; bj < 2; ++bj) { f32x4 v0 = acc[ai][bj][m][0], v1 = acc[ai][bj][m][1];
                    if (mode == 2) { const float* q = nyq + (u.pn >> 1) * 512 + (u.pn & 1) * 256 + bj * HALF + wc * 32 + 8 * fq; const float sg = (fr & 1) ? (-1.0f / 512.0f) : (1.0f / 512.0f);
                        v0 += *(const f32x4*)q * sg; v1 += *(const f32x4*)(q + 4) * sg; }
                    u32x4 w; w.x = cvt_pk_bf16(v0[0], v0[1]); w.y = cvt_pk_bf16(v0[2], v0[3]); w.z = cvt_pk_bf16(v1[0], v1[1]); w.w = cvt_pk_bf16(v1[2], v1[3]);
                    *(u32x4*)(rowp + bj * HALF) = w; } }
    }
};
__device__ __forceinline__ float silu_mul(float a, float b) { return (a * b) * __builtin_amdgcn_rcpf(1.0f + __builtin_amdgcn_exp2f(-a)); }
struct EpiSwiGLU {
    static constexpr bool PERM = true, AFTER_DRAIN = false;
    bf16_t* O; int dry;
    __device__ __forceinline__ void operator()(const f32x4 (&acc)[2][2][4][2], const Unit& u, int wr, int wc, int fr, int fq) const {
        if (dry) return;
        bf16_t* base = O + ((size_t)(u.pm * (FF / 64) + u.pn * 2 + (wc >> 1)) * 256 + wr * 64 + fr) * 64 + (wc & 1) * 32 + 8 * fq;
#pragma unroll
        for (int ai = 0; ai < 2; ++ai)
#pragma unroll
            for (int m = 0; m < 4; ++m) { bf16_t* rowp = base + (size_t)(ai * HALF + m * 16) * 64;
                const f32x4 g0 = acc[ai][0][m][0], g1 = acc[ai][0][m][1], u0 = acc[ai][1][m][0], u1 = acc[ai][1][m][1];
                u32x4 w; w.x = cvt_pk_bf16(silu_mul(g0[0], u0[0]), silu_mul(g0[1], u0[1])); w.y = cvt_pk_bf16(silu_mul(g0[2], u0[2]), silu_mul(g0[3], u0[3]));
                w.z = cvt_pk_bf16(silu_mul(g1[0], u1[0]), silu_mul(g1[1], u1[1])); w.w = cvt_pk_bf16(silu_mul(g1[2], u1[2]), silu_mul(g1[3], u1[3]));
                *(u32x4*)rowp = w; }
    }
};

template <class Epi, class Sched, bool ALIGN_EPI = false, bool SP2 = false>
__device__ __forceinline__ void gemm_phase(LAS unsigned char* lds, const Gemm g, const Sched& S, const Epi& E) {
    const int tid = tid_opaque(), wid = __builtin_amdgcn_readfirstlane(tid >> 6), lane = tid & 63, wr = wid >> 2, wc = wid & 3, fr = lane & 15, fq = lane >> 4;
    const int K = g.K, nt = K / BK;
    unsigned voffA[2], voffB[2];
#pragma unroll
    for (int i = 0; i < 2; ++i) { int R, C; stage_rc(tid * 16 + i * 8192, R, C); const int Rb = Epi::PERM ? ((R & ~31) + perm32(R & 31)) : R;
        voffA[i] = (unsigned)(R * (g.ablk ? BK : K) + C) * 2u; voffB[i] = (unsigned)(Rb * K + C) * 2u; }
    const size_t kstep = (size_t)(BK * 2);
    const size_t hstep = (size_t)HALF * K * 2;
    const size_t tstep = 2 * hstep;
    const size_t kstepA = g.ablk ? (size_t)BM * BK * 2 : kstep, hstepA = g.ablk ? (size_t)HALF * BK * 2 : hstep;
    const unsigned ldsw = (unsigned)wid * 1024u;
    const int aoff = lds_byte(wr * 64 + fr, fq * 8), boff = lds_byte(wc * 32 + fr, fq * 8);
#define PG8_SA(b, h) (((b) * 2 + (h)) * HTB)
#define PG8_SB(b, h) ((4 + (b) * 2 + (h)) * HTB)
#define PG8_STAGE(bufoff, gbase, voff) do { _Pragma("unroll") for (int _i = 0; _i < 2; ++_i) \
        __builtin_amdgcn_global_load_lds((const unsigned*)((const char*)(gbase) + (voff)[_i]), (LAS unsigned*)(lds + (bufoff) + ldsw + _i * 8192), 16, 0, 0); } while (0)
#define PG8_LDA(dst, b, h) do { _Pragma("unroll") for (int m = 0; m < 4; ++m) _Pragma("unroll") for (int k = 0; k < 2; ++k) dst[m][k] = *(const LAS bf16x8*)(lds + PG8_SA(b, h) + aoff + m * 2048 + k * 1024); } while (0)
#define PG8_LDB(dst, b, h) do { _Pragma("unroll") for (int n = 0; n < 2; ++n) _Pragma("unroll") for (int k = 0; k < 2; ++k) dst[n][k] = *(const LAS bf16x8*)(lds + PG8_SB(b, h) + boff + n * 2048 + k * 1024); } while (0)
#define PG8_MMA(ai, bj, At, Bt) do { __builtin_amdgcn_s_setprio(1); _Pragma("unroll") for (int m = 0; m < 4; ++m) _Pragma("unroll") for (int n = 0; n < 2; ++n) _Pragma("unroll") for (int k = 0; k < 2; ++k) \
        acc[ai][bj][m][n] = __builtin_amdgcn_mfma_f32_16x16x32_bf16(Bt[n][k], At[m][k], acc[ai][bj][m][n], 0, 0, 0); __builtin_amdgcn_s_setprio(0); } while (0)
#define PG8_WAIT_V(n) asm volatile("s_waitcnt vmcnt(" #n ")" ::: "memory")
#define PG8_WAIT_L(n) asm volatile("s_waitcnt lgkmcnt(" #n ")" ::: "memory")
#define PG8_BAR __builtin_amdgcn_s_barrier()
#define PG8_SCHED __builtin_amdgcn_sched_barrier(0)
    Unit cur, nxt; int ui = 0;
    if (!S.next(0, cur)) return;
    f32x4 acc[2][2][4][2];
#pragma unroll
    for (int a = 0; a < 2; ++a)
#pragma unroll
        for (int b = 0; b < 2; ++b)
#pragma unroll
            for (int m = 0; m < 4; ++m)
#pragma unroll
                for (int n = 0; n < 2; ++n) acc[a][b][m][n] = (f32x4){0.f, 0.f, 0.f, 0.f};
    bf16x8 At[4][2], B0[2][2], B1[2][2];
    const char* cA = (const char*)g.A + (size_t)cur.pm * tstep; const char* cB = (const char*)g.Bt + (size_t)cur.pn * tstep;
    S.a_ready(cur);
    if constexpr (SP2) {
        PG8_STAGE(PG8_SB(0, 0), cB, voffB); PG8_STAGE(PG8_SB(0, 1), cB + hstep, voffB); PG8_STAGE(PG8_SA(0, 0), cA, voffA); PG8_STAGE(PG8_SA(0, 1), cA + hstepA, voffA);
        if (wr == 1) PG8_BAR;
        PG8_WAIT_V(2); PG8_BAR;
        PG8_STAGE(PG8_SB(1, 0), cB + kstep, voffB); PG8_STAGE(PG8_SA(1, 0), cA + kstepA, voffA); PG8_STAGE(PG8_SB(1, 1), cB + hstep + kstep, voffB);
        PG8_WAIT_V(6); PG8_BAR;
    } else {
        PG8_STAGE(PG8_SB(0, 0), cB, voffB); PG8_STAGE(PG8_SA(0, 0), cA, voffA); PG8_STAGE(PG8_SB(0, 1), cB + hstep, voffB); PG8_STAGE(PG8_SA(0, 1), cA + hstep, voffA);
        if (wr == 1) PG8_BAR;
        PG8_WAIT_V(4); PG8_BAR;
        PG8_STAGE(PG8_SB(1, 0), cB + kstep, voffB); PG8_STAGE(PG8_SA(1, 0), cA + kstep, voffA); PG8_STAGE(PG8_SB(1, 1), cB + hstep + kstep, voffB);
        PG8_WAIT_V(6); PG8_BAR;
    }
    for (;;) {
        const bool has_next = S.next(ui + 1, nxt);
        const char* nA = has_next ? (const char*)g.A + (size_t)nxt.pm * tstep : cA + (size_t)(nt - 2) * kstepA; const char* nB = has_next ? (const char*)g.Bt + (size_t)nxt.pn * tstep : cB + (size_t)(nt - 2) * kstep;
        for (int t = 0; t < nt; t += 2) {
            const bool last = (t == nt - 2);
            const char* a1 = cA + (size_t)(t + 1) * kstepA;
            const char* a2 = last ? nA : cA + (size_t)(t + 2) * kstepA; const char* b2 = last ? nB : cB + (size_t)(t + 2) * kstep;
            const char* a3 = a2 + kstepA; const char* b3 = b2 + kstep;
            if (last && has_next) S.a_ready(nxt);
            if constexpr (SP2) {
            PG8_LDB(B0, 0, 0); PG8_LDB(B1, 0, 1); PG8_SCHED; PG8_LDA(At, 0, 0); PG8_STAGE(PG8_SA(1, 1), a1 + hstepA, voffA);
            PG8_WAIT_V(8); PG8_WAIT_L(0); PG8_BAR; PG8_MMA(0, 0, At, B0); PG8_MMA(0, 1, At, B1); PG8_BAR; PG8_SCHED;
            PG8_LDA(At, 0, 1); PG8_STAGE(PG8_SB(0, 0), b2, voffB); PG8_STAGE(PG8_SB(0, 1), b2 + hstep, voffB); PG8_STAGE(PG8_SA(0, 0), a2, voffA);
            PG8_WAIT_V(8); PG8_WAIT_L(0); PG8_BAR; PG8_MMA(1, 0, At, B0); PG8_MMA(1, 1, At, B1); PG8_BAR; PG8_SCHED;
            PG8_LDB(B0, 1, 0); PG8_LDB(B1, 1, 1); PG8_SCHED; PG8_LDA(At, 1, 0); PG8_STAGE(PG8_SA(0, 1), a2 + hstepA, voffA);
            PG8_WAIT_V(8); PG8_WAIT_L(0); PG8_BAR; PG8_MMA(0, 0, At, B0); PG8_MMA(0, 1, At, B1); PG8_BAR; PG8_SCHED;
            PG8_LDA(At, 1, 1); PG8_STAGE(PG8_SB(1, 0), b3, voffB); PG8_STAGE(PG8_SB(1, 1), b3 + hstep, voffB); PG8_STAGE(PG8_SA(1, 0), a3, voffA);
            PG8_WAIT_V(8); PG8_WAIT_L(0); PG8_BAR; PG8_MMA(1, 0, At, B0); PG8_MMA(1, 1, At, B1); PG8_BAR; PG8_SCHED;
            } else {
            PG8_LDB(B0, 0, 0); PG8_SCHED; PG8_LDA(At, 0, 0); PG8_STAGE(PG8_SA(1, 1), a1 + hstep, voffA);
            PG8_WAIT_L(8); PG8_BAR; PG8_WAIT_L(0); PG8_MMA(0, 0, At, B0); PG8_BAR; PG8_SCHED;
            PG8_LDB(B1, 0, 1); PG8_STAGE(PG8_SB(0, 0), b2, voffB);
            PG8_BAR; PG8_WAIT_L(0); PG8_MMA(0, 1, At, B1); PG8_BAR;
            PG8_LDA(At, 0, 1); PG8_STAGE(PG8_SA(0, 0), a2, voffA);
            PG8_BAR; PG8_WAIT_L(0); PG8_MMA(1, 0, At, B0); PG8_BAR; PG8_SCHED;
            PG8_STAGE(PG8_SB(0, 1), b2 + hstep, voffB);
            PG8_WAIT_V(6); PG8_BAR; PG8_MMA(1, 1, At, B1); PG8_BAR;
            PG8_LDB(B0, 1, 0); PG8_SCHED; PG8_LDA(At, 1, 0); PG8_STAGE(PG8_SA(0, 1), a2 + hstep, voffA);
            PG8_WAIT_L(8); PG8_BAR; PG8_WAIT_L(0); PG8_MMA(0, 0, At, B0); PG8_BAR; PG8_SCHED;
            PG8_LDB(B1, 1, 1); PG8_STAGE(PG8_SB(1, 0), b3, voffB);
            PG8_BAR; PG8_WAIT_L(0); PG8_MMA(0, 1, At, B1); PG8_BAR;
            PG8_LDA(At, 1, 1); PG8_STAGE(PG8_SA(1, 0), a3, voffA);
            PG8_BAR; PG8_WAIT_L(0); PG8_MMA(1, 0, At, B0); PG8_BAR; PG8_SCHED;
            PG8_STAGE(PG8_SB(1, 1), b3 + hstep, voffB);
            PG8_WAIT_V(6); PG8_BAR; PG8_MMA(1, 1, At, B1); PG8_BAR;
            }
        }
        if constexpr (ALIGN_EPI) { if (wr == 0) PG8_BAR; }
        if constexpr (!Epi::AFTER_DRAIN) { E(acc, cur, wr, wc, fr, fq); S.done(cur); }
        if (!has_next) break;
#pragma unroll
        for (int a = 0; a < 2; ++a)
#pragma unroll
            for (int b = 0; b < 2; ++b)
#pragma unroll
                for (int m = 0; m < 4; ++m)
#pragma unroll
                    for (int n = 0; n < 2; ++n) acc[a][b][m][n] = (f32x4){0.f, 0.f, 0.f, 0.f};
        cur = nxt; cA = nA; cB = nB; ++ui;
        if constexpr (ALIGN_EPI) { if (wr == 1) PG8_BAR; }
    }
    PG8_WAIT_V(0);
    if constexpr (!ALIGN_EPI) { if (wr == 0) PG8_BAR; }
    PG8_BAR;
#undef PG8_SA
#undef PG8_SB
#undef PG8_STAGE
#undef PG8_LDA
#undef PG8_LDB
#undef PG8_MMA
#undef PG8_WAIT_V
#undef PG8_WAIT_L
#undef PG8_BAR
#undef PG8_SCHED
}
}

__device__ __forceinline__ float wave_sum(float v) {
    v += __shfl_xor(v, 32); v += __shfl_xor(v, 16); v += __shfl_xor(v, 8); v += __shfl_xor(v, 4); v += __shfl_xor(v, 2); v += __shfl_xor(v, 1); return v;
}
__device__ __forceinline__ float bf_lo(unsigned u) { return __uint_as_float(u << 16); }
__device__ __forceinline__ float bf_hi(unsigned u) { return __uint_as_float(u & 0xffff0000u); }

struct NormRow { f32x4 x[4]; u32x4 y[2]; };
__device__ __forceinline__ NormRow norm_load_row(const bf16_t* y, const float* xin, bool xin24, int row, int lane, bool has_y) {
    NormRow r; const float* xr = xin + (size_t)row * DM; const unsigned char* xb = (const unsigned char*)xr;
    if (xin24) {
        const u32x4 h0 = __builtin_nontemporal_load((const u32x4*)(xb + lane * 16)), h1 = __builtin_nontemporal_load((const u32x4*)(xb + 1024 + lane * 16));
        const u32x2 l0 = __builtin_nontemporal_load((const u32x2*)(xb + 2048 + lane * 8)), l1 = __builtin_nontemporal_load((const u32x2*)(xb + 2560 + lane * 8));
        r.x[0] = (f32x4){__uint_as_float(h0.x), __uint_as_float(h0.y), __uint_as_float(h0.z), __uint_as_float(h0.w)};
        r.x[1] = (f32x4){__uint_as_float(h1.x), __uint_as_float(h1.y), __uint_as_float(h1.z), __uint_as_float(h1.w)};
        r.x[2] = (f32x4){__uint_as_float(l0.x), __uint_as_float(l0.y), __uint_as_float(l1.x), __uint_as_float(l1.y)}; r.x[3] = (f32x4){0.f, 0.f, 0.f, 0.f};
    } else {
        r.x[0] = __builtin_nontemporal_load((const f32x4*)(xr + lane * 8)); r.x[1] = __builtin_nontemporal_load((const f32x4*)(xr + lane * 8 + 4));
        r.x[2] = __builtin_nontemporal_load((const f32x4*)(xr + 512 + lane * 8)); r.x[3] = __builtin_nontemporal_load((const f32x4*)(xr + 512 + lane * 8 + 4));
    }
    if (has_y) { r.y[0] = __builtin_nontemporal_load((const u32x4*)(y + (size_t)row * DM + lane * 8)); r.y[1] = __builtin_nontemporal_load((const u32x4*)(y + (size_t)row * DM + 512 + lane * 8)); }
    else { r.y[0] = (u32x4){0u, 0u, 0u, 0u}; r.y[1] = (u32x4){0u, 0u, 0u, 0u}; }
    return r;
}
__device__ __forceinline__ f32x4 x24_dec4(unsigned wa, unsigned wb, unsigned l) {
    return (f32x4){__uint_as_float((wa << 16) | ((l & 0xffu) << 8)), __uint_as_float((wa & 0xffff0000u) | (l & 0xff00u)), __uint_as_float((wb << 16) | ((l >> 8) & 0xff00u)), __uint_as_float((wb & 0xffff0000u) | ((l >> 16) & 0xff00u))};
}
__device__ __forceinline__ unsigned x24_lo4(f32x4 v, unsigned& ha, unsigned& hb) {
    const unsigned b0 = __float_as_uint(v[0]) + 0x80u, b1 = __float_as_uint(v[1]) + 0x80u, b2 = __float_as_uint(v[2]) + 0x80u, b3 = __float_as_uint(v[3]) + 0x80u;
    ha = (b0 >> 16) | (b1 & 0xffff0000u); hb = (b2 >> 16) | (b3 & 0xffff0000u);
    return ((b0 >> 8) & 0xffu) | (b1 & 0xff00u) | ((b2 << 8) & 0xff0000u) | ((b3 << 16) & 0xff000000u);
}
__device__ __forceinline__ f32x4 bf4(unsigned a, unsigned b) { return (f32x4){bf_lo(a), bf_hi(a), bf_lo(b), bf_hi(b)}; }
__device__ __forceinline__ u32x4 pack8(f32x4 a, f32x4 b) { u32x4 w; w.x = pg8::cvt_pk_bf16(a[0], a[1]); w.y = pg8::cvt_pk_bf16(a[2], a[3]); w.z = pg8::cvt_pk_bf16(b[0], b[1]); w.w = pg8::cvt_pk_bf16(b[2], b[3]); return w; }
__device__ __forceinline__ float sumsq4(f32x4 v) { return (v[0] * v[0] + v[1] * v[1]) + (v[2] * v[2] + v[3] * v[3]); }
__device__ __forceinline__ void norm_rows_of(int qq, int& bk, int& r0, int& r1) {
    const int x = (qq >> 3) & 7, pl = ((qq >> 6) << 3) | (qq & 7), b = 2 * x + (pl >> 10), k = pl & 1023;
    bk = b * 1024 + k; r0 = b * SEQ + k; r1 = b * SEQ + (k == 0 ? SEQ / 2 : SEQ - k);
}
struct NormOut { f32x4 a, b, c, d; float rs; };
__device__ __forceinline__ NormOut norm_one(const NormRow& r, float* xout, int row, int lane, f32x4 g0, f32x4 g1, f32x4 g2, f32x4 g3, float coef, bool xin24, bool xout24, bool has_y, bool has_h) {
    const unsigned w0 = __float_as_uint(r.x[0][0]), w1 = __float_as_uint(r.x[0][1]), w2 = __float_as_uint(r.x[0][2]), w3 = __float_as_uint(r.x[0][3]);
    const unsigned w4 = __float_as_uint(r.x[1][0]), w5 = __float_as_uint(r.x[1][1]), w6 = __float_as_uint(r.x[1][2]), w7 = __float_as_uint(r.x[1][3]);
    const unsigned la = __float_as_uint(r.x[2][0]), lb = __float_as_uint(r.x[2][1]), lc = __float_as_uint(r.x[2][2]), ld = __float_as_uint(r.x[2][3]);
    NormOut o;
    o.a = xin24 ? x24_dec4(w0, w1, la) : r.x[0]; o.b = xin24 ? x24_dec4(w2, w3, lb) : r.x[1]; o.c = xin24 ? x24_dec4(w4, w5, lc) : r.x[2]; o.d = xin24 ? x24_dec4(w6, w7, ld) : r.x[3];
    if (has_y) {
        const f32x4 v0 = bf4(r.y[0].x, r.y[0].y), v1 = bf4(r.y[0].z, r.y[0].w), v2 = bf4(r.y[1].x, r.y[1].y), v3 = bf4(r.y[1].z, r.y[1].w);
        float s = (sumsq4(v0) + sumsq4(v1)) + (sumsq4(v2) + sumsq4(v3));
        s = wave_sum(s);
        const float cy = coef * rsqrtf(s * (1.0f / DM) + EPS);
        o.a += v0 * g0 * cy; o.b += v1 * g1 * cy; o.c += v2 * g2 * cy; o.d += v3 * g3 * cy;
    }
    if (xout) {
        float* xr = xout + (size_t)row * DM; unsigned char* xb = (unsigned char*)xr;
        if (xout24) {
            unsigned h0, h1, h2, h3, h4, h5, h6, h7; u32x2 l0, l1;
            l0.x = x24_lo4(o.a, h0, h1); l0.y = x24_lo4(o.b, h2, h3); l1.x = x24_lo4(o.c, h4, h5); l1.y = x24_lo4(o.d, h6, h7);
            __builtin_nontemporal_store((u32x4){h0, h1, h2, h3}, (u32x4*)(xb + lane * 16)); __builtin_nontemporal_store((u32x4){h4, h5, h6, h7}, (u32x4*)(xb + 1024 + lane * 16));
            __builtin_nontemporal_store(l0, (u32x2*)(xb + 2048 + lane * 8)); __builtin_nontemporal_store(l1, (u32x2*)(xb + 2560 + lane * 8));
        } else {
            __builtin_nontemporal_store(o.a, (f32x4*)(xr + lane * 8)); __builtin_nontemporal_store(o.b, (f32x4*)(xr + lane * 8 + 4));
            __builtin_nontemporal_store(o.c, (f32x4*)(xr + 512 + lane * 8)); __builtin_nontemporal_store(o.d, (f32x4*)(xr + 512 + lane * 8 + 4));
        }
    }
    o.rs = 0.f;
    if (has_h) { float s = (sumsq4(o.a) + sumsq4(o.b)) + (sumsq4(o.c) + sumsq4(o.d)); s = wave_sum(s); o.rs = rsqrtf(s * (1.0f / DM) + EPS); }
    return o;
}
__device__ __forceinline__ void norm_phase(const bf16_t* y, const float* xin, float* xout, bf16_t* h, bf16_t* hf, const float* gpost, const float* gpre, float coef, int G, int c, bool xin24, bool xout24) {
    const int tid = tid_opaque(); const int lane = tid & 63, wid = tid >> 6;
    const int gw = c * 8 + wid, nw = G * 8;
    const bool has_y = (y != nullptr), has_h = (h != nullptr), fold = (hf != nullptr);
    const f32x4 z4 = (f32x4){0.f, 0.f, 0.f, 0.f};
    const f32x4 gp0 = has_y ? *(const f32x4*)(gpost + lane * 8) : z4, gp1 = has_y ? *(const f32x4*)(gpost + lane * 8 + 4) : z4, gp2 = has_y ? *(const f32x4*)(gpost + 512 + lane * 8) : z4, gp3 = has_y ? *(const f32x4*)(gpost + 512 + lane * 8 + 4) : z4;
    const f32x4 gq0 = has_h ? *(const f32x4*)(gpre + lane * 8) : z4, gq1 = has_h ? *(const f32x4*)(gpre + lane * 8 + 4) : z4, gq2 = has_h ? *(const f32x4*)(gpre + 512 + lane * 8) : z4, gq3 = has_h ? *(const f32x4*)(gpre + 512 + lane * 8 + 4) : z4;
    for (int q = gw; q < NTOK / 2; q += nw) {
        int r0, r1, bk; norm_rows_of(q, bk, r0, r1);
        const NormRow ra = norm_load_row(y, xin, xin24, r0, lane, has_y), rb = norm_load_row(y, xin, xin24, r1, lane, has_y);
        const NormOut A = norm_one(ra, xout, r0, lane, gp0, gp1, gp2, gp3, coef, xin24, xout24, has_y, has_h);
        const NormOut B = norm_one(rb, xout, r1, lane, gp0, gp1, gp2, gp3, coef, xin24, xout24, has_y, has_h);
        if (has_h) {
            const float fs = ((bk & 1023) == 0) ? 0.f : 1.f;
            const size_t oe = ((size_t)(bk >> 10) * 2048 + (bk & 1023)) * DM, oo = oe + (size_t)1024 * DM;
            const f32x4 a0 = A.a * gq0 * A.rs, a1 = A.b * gq1 * A.rs, a2 = A.c * gq2 * A.rs, a3 = A.d * gq3 * A.rs;
            const f32x4 b0 = B.a * gq0 * B.rs, b1 = B.b * gq1 * B.rs, b2 = B.c * gq2 * B.rs, b3 = B.d * gq3 * B.rs;
            *(u32x4*)(h + (size_t)r0 * DM + lane * 8) = pack8(a0, a1); *(u32x4*)(h + (size_t)r0 * DM + 512 + lane * 8) = pack8(a2, a3);
            *(u32x4*)(h + (size_t)r1 * DM + lane * 8) = pack8(b0, b1); *(u32x4*)(h + (size_t)r1 * DM + 512 + lane * 8) = pack8(b2, b3);
            if (fold) {
                *(u32x4*)(hf + oe + lane * 8) = pack8(a0 + b0 * fs, a1 + b1 * fs); *(u32x4*)(hf + oe + 512 + lane * 8) = pack8(a2 + b2 * fs, a3 + b3 * fs);
                *(u32x4*)(hf + oo + lane * 8) = pack8((a0 - b0) * fs, (a1 - b1) * fs); *(u32x4*)(hf + oo + 512 + lane * 8) = pack8((a2 - b2) * fs, (a3 - b3) * fs);
            }
        }
    }
}

struct TrJob { const float* src; bf16_t* dst; int N, tn, ldd, kind, t0; };
__device__ __forceinline__ TrJob tr_decode(const Params& p, int R) {
    constexpr int TPL = 4480;
    bf16_t* WGU = (bf16_t*)(p.ws + OFF_WGU); bf16_t* WD = (bf16_t*)(p.ws + OFF_WD); bf16_t* WO = (bf16_t*)(p.ws + OFF_WO);
    const int ti0 = R * 4, l = ti0 / TPL, r = ti0 % TPL; int m = r / 704; if (m > 6) m = 6;
    TrJob j; j.t0 = r - m * 704;
    if (m == 0) { j.src = p.in[2] + (size_t)l * 1024 * 2816; j.N = 2816; j.tn = 44; j.dst = WGU + (size_t)(l * 2 + 0) * 5632 * 1024; j.ldd = 1024; j.kind = 0; }
    else if (m == 1) { j.src = p.in[3] + (size_t)l * 1024 * 2816; j.N = 2816; j.tn = 44; j.dst = WGU + (size_t)(l * 2 + 0) * 5632 * 1024; j.ldd = 1024; j.kind = 1; }
    else if (m == 2) { j.src = p.in[4] + (size_t)l * 2816 * 1024; j.N = 1024; j.tn = 16; j.dst = WD + (size_t)(l * 2 + 0) * 1024 * 2816; j.ldd = 2816; j.kind = 2; }
    else if (m == 3) { j.src = p.in[14] + (size_t)l * 1024 * 2816; j.N = 2816; j.tn = 44; j.dst = WGU + (size_t)(l * 2 + 1) * 5632 * 1024; j.ldd = 1024; j.kind = 0; }
    else if (m == 4) { j.src = p.in[15] + (size_t)l * 1024 * 2816; j.N = 2816; j.tn = 44; j.dst = WGU + (size_t)(l * 2 + 1) * 5632 * 1024; j.ldd = 1024; j.kind = 1; }
    else if (m == 5) { j.src = p.in[16] + (size_t)l * 2816 * 1024; j.N = 1024; j.tn = 16; j.dst = WD + (size_t)(l * 2 + 1) * 1024 * 2816; j.ldd = 2816; j.kind = 2; }
    else { j.src = p.in[11] + (size_t)l * 1024 * 1024; j.N = 1024; j.tn = 16; j.dst = WO + (size_t)l * 1024 * 1024; j.ldd = 1024; j.kind = 2; }
    return j;
}
__device__ __forceinline__ void tr_load(f32x4 (&v)[4][2], const TrJob& j, int tid) {
#pragma unroll
    for (int q = 0; q < 4; ++q) { const int t = j.t0 + q, kt = t / j.tn, ntile = t - kt * j.tn;
#pragma unroll
        for (int i = 0; i < 2; ++i) v[q][i] = __builtin_nontemporal_load((const f32x4*)(j.src + (size_t)(kt * 64 + (tid >> 4) + 32 * i) * j.N + ntile * 64 + (tid & 15) * 4)); }
}
__device__ __forceinline__ void transpose_phase(const Params& p, LAS unsigned char* lds, int G) {
    LAS float* T = (LAS float*)lds;
    const int tid = tid_opaque();
    const int nrounds = NL * 4480 / 4;
    f32x4 v[4][2];
    TrJob cur, nxt;
    if ((int)blockIdx.x < nrounds) { cur = tr_decode(p, blockIdx.x); tr_load(v, cur, tid); }
    for (int R = blockIdx.x; R < nrounds; R += G) {
#pragma unroll
        for (int q = 0; q < 4; ++q)
#pragma unroll
            for (int i = 0; i < 2; ++i) { LAS float* d = T + q * 4160 + ((tid >> 4) + 32 * i) * 65 + (tid & 15) * 4; d[0] = v[q][i][0]; d[1] = v[q][i][1]; d[2] = v[q][i][2]; d[3] = v[q][i][3]; }
        __syncthreads();
        nxt = cur;
        if (R + G < nrounds) { nxt = tr_decode(p, R + G); tr_load(v, nxt, tid); }
#pragma unroll
        for (int q = 0; q < 4; ++q) { const int t = cur.t0 + q, kt = t / cur.tn, ntile = t - kt * cur.tn;
            const int nl = tid >> 3, k8 = (tid & 7) * 8; const int n = ntile * 64 + nl;
            const int drow = (cur.kind == 2) ? n : ((n >> 7) * 256 + (n & 127) + (cur.kind == 1 ? 128 : 0));
            const LAS float* s = T + q * 4160 + k8 * 65 + nl;
            const float sc = (cur.kind == 0) ? 1.4426950408889634f : (cur.kind == 1) ? 0.6931471805599453f : 1.0f;
            u32x4 w; w.x = pg8::cvt_pk_bf16(s[0] * sc, s[65] * sc); w.y = pg8::cvt_pk_bf16(s[130] * sc, s[195] * sc); w.z = pg8::cvt_pk_bf16(s[260] * sc, s[325] * sc); w.w = pg8::cvt_pk_bf16(s[390] * sc, s[455] * sc);
            *(u32x4*)(cur.dst + (size_t)drow * cur.ldd + kt * 64 + k8) = w; }
        __syncthreads();
        cur = nxt;
    }
}

__device__ __forceinline__ void tm_phase(const Params& p, int G) {
    bf16_t* TM = (bf16_t*)(p.ws + OFF_TM);
    const int total = 2048 * 2048 / 8; const int tid = tid_opaque();
    for (int e = blockIdx.x * NTHREADS + tid; e < total; e += G * NTHREADS) {
        const int s = e >> 8, k0 = (e & 255) * 8; float v[8];
#pragma unroll
        for (int j = 0; j < 8; ++j) { const int k = k0 + j, kk = k & 1023; const int ph = (s * kk) & 2047; const float a = (float)ph * (1.0f / 1024.0f);
            v[j] = (k < 1024) ? cospif(a) * (1.0f / 512.0f) : -sinpif(a) * (1.0f / 512.0f); }
        u32x4 w; w.x = pg8::cvt_pk_bf16(v[0], v[1]); w.y = pg8::cvt_pk_bf16(v[2], v[3]); w.z = pg8::cvt_pk_bf16(v[4], v[5]); w.w = pg8::cvt_pk_bf16(v[6], v[7]);
        *(u32x4*)(TM + (size_t)e * 8) = w;
    }
}

__device__ __forceinline__ void nyq_phase(const bf16_t* WA, const bf16_t* H, float* nyq, int G, int c) {
    const int tid = tid_opaque(), lane = tid & 63, wid = tid >> 6;
    for (int tt = c * 8 + wid; tt < NB * 512; tt += G * 8) {
        const int x = (tt >> 3) & 7, tl = ((tt >> 6) << 3) | (tt & 7), b = 2 * x + (tl >> 9), n = tl & 511, t = b * 512 + n;
        const bf16_t* w = WA + (size_t)n * 1024 + lane * 8; const bf16_t* h = H + ((size_t)b * SEQ + 1024) * 1024 + lane * 8;
        float acc = 0.f;
#pragma unroll
        for (int j = 0; j < 2; ++j) { const u32x4 a = *(const u32x4*)(w + 512 * j), c = *(const u32x4*)(h + 512 * j);
            acc += bf_lo(a.x) * bf_lo(c.x) + bf_hi(a.x) * bf_hi(c.x) + bf_lo(a.y) * bf_lo(c.y) + bf_hi(a.y) * bf_hi(c.y) + bf_lo(a.z) * bf_lo(c.z) + bf_hi(a.z) * bf_hi(c.z) + bf_lo(a.w) * bf_lo(c.w) + bf_hi(a.w) * bf_hi(c.w); }
        acc = wave_sum(acc);
        if (lane == 0) nyq[t] = acc;
    }
}

__device__ __forceinline__ void mcs_phase(const Params& p, LAS unsigned char* lds, int G) {
    LAS float* tab = (LAS float*)lds;
    const int tid = tid_opaque();
    if (tid < 128) { const float a = (float)tid * (1.0f / 64.0f); tab[tid] = cospif(a); tab[128 + tid] = sinpif(a); }
    __syncthreads();
    float* MCS = (float*)(p.ws + OFF_MCS); const float* fw = p.in[8];
    const int total = NL * 4 * 128 * 256;
    for (int e = blockIdx.x * NTHREADS + tid; e < total; e += G * NTHREADS) {
        const int col = e & 255, c = (e >> 8) & 127, lh = e >> 15; const int part = col >> 7, d = col & 127;
        const float* w = fw + (size_t)lh * 128 * 128 + d; float acc = 0.f;
        for (int k = 0; k < 128; ++k) acc += tab[part * 128 + ((c * k) & 127)] * w[(size_t)k * 128];
        MCS[e] = acc;
    }
    __syncthreads();
}

__device__ __forceinline__ void fold_phase(const Params& p, LAS unsigned char* lds, int G) {
    LAS float* Wt = (LAS float*)lds;
    LAS float* Mt = (LAS float*)(lds + 128 * 132 * 4);
    const int tid = tid_opaque();
    const float* MCS = (const float*)(p.ws + OFF_MCS);
    bf16_t* WA = (bf16_t*)(p.ws + OFF_WA); bf16_t* WB = (bf16_t*)(p.ws + OFF_WB);
    const int nitems = NL * 24 * 8;
    for (int it = blockIdx.x; it < nitems; it += G) {
        const int kb = it & 7, ch = (it >> 3) % 24, l = (it >> 3) / 24;
        const float* win = p.in[7] + (size_t)l * 1024 * 1024;
        const float* msrc; int ldm, wcol; bf16_t* dst; const float* scl = nullptr;
        if (ch < 16) { const int h = ch >> 2, cc = ch & 3; msrc = MCS + (size_t)(l * 4 + h) * 128 * 256 + cc * 64; ldm = 256; wcol = h * 128;
            dst = WA + ((size_t)l * 1024 + (cc >> 1) * 512 + h * 128 + (cc & 1) * 64) * 1024; }
        else { const int g = (ch - 16) >> 1, d0 = ((ch - 16) & 1) * 64; msrc = p.in[9] + (size_t)(l * 4 + g) * 128 * 128 + d0; ldm = 128; wcol = 512 + g * 128;
            dst = WB + ((size_t)l * 512 + g * 128 + d0) * 1024; scl = p.in[10] + (size_t)l * 512 + g * 128 + d0; }
#pragma unroll
        for (int i = 0; i < 8; ++i) { const int kk = (tid >> 5) + 16 * i, c4 = (tid & 31) * 4;
            *(LAS f32x4*)(Wt + kk * 132 + c4) = *(const f32x4*)(win + (size_t)(kb * 128 + kk) * 1024 + wcol + c4); }
#pragma unroll
        for (int i = 0; i < 4; ++i) { const int c = (tid >> 4) + 32 * i, j4 = (tid & 15) * 4;
            f32x4 mv = *(const f32x4*)(msrc + (size_t)c * ldm + j4);
            if (scl) mv *= *(const f32x4*)(scl + j4);
            *(LAS f32x4*)(Mt + c * 64 + j4) = mv; }
        __syncthreads();
        const int j4 = (tid & 15) * 4, k4 = (tid >> 4) * 4;
        f32x4 acc[4];
#pragma unroll
        for (int q = 0; q < 4; ++q) acc[q] = (f32x4){0.f, 0.f, 0.f, 0.f};
        for (int c4 = 0; c4 < 32; ++c4) {
            const f32x4 m0 = *(const LAS f32x4*)(Mt + (c4 * 4 + 0) * 64 + j4), m1 = *(const LAS f32x4*)(Mt + (c4 * 4 + 1) * 64 + j4);
            const f32x4 m2 = *(const LAS f32x4*)(Mt + (c4 * 4 + 2) * 64 + j4), m3 = *(const LAS f32x4*)(Mt + (c4 * 4 + 3) * 64 + j4);
#pragma unroll
            for (int q = 0; q < 4; ++q) { const f32x4 w = *(const LAS f32x4*)(Wt + (k4 + q) * 132 + c4 * 4); acc[q] += (m0 * w[0] + m1 * w[1]) + (m2 * w[2] + m3 * w[3]); }
        }
#pragma unroll
        for (int jj = 0; jj < 4; ++jj) { u32x2 w; w.x = pg8::cvt_pk_bf16(acc[0][jj], acc[1][jj]); w.y = pg8::cvt_pk_bf16(acc[2][jj], acc[3][jj]);
            *(u32x2*)(dst + (size_t)(j4 + jj) * 1024 + kb * 128 + k4) = w; }
        __syncthreads();
    }
}

template <int R> __device__ __forceinline__ void pool_group(const LAS unsigned char* tile, int tl, int s, int g, int c16, bf16_t* orow) {
    float a[8];
#pragma unroll
    for (int q = 0; q < 8; ++q) a[q] = 0.f;
    const LAS unsigned char* base = tile + (tl + 8 - R) * 1024 + g * 256 + c16 * 16;
    u32x4 c;
#pragma unroll
    for (int j = 0; j <= 2 * R; ++j) { const u32x4 v = *(const LAS u32x4*)(base + j * 1024); if (j == R) c = v;
        a[0] += bf_lo(v.x); a[1] += bf_hi(v.x); a[2] += bf_lo(v.y); a[3] += bf_hi(v.y); a[4] += bf_lo(v.z); a[5] += bf_hi(v.z); a[6] += bf_lo(v.w); a[7] += bf_hi(v.w); }
    const int lo = (s - R < 0) ? 0 : s - R, hi = (s + R > SEQ - 1) ? SEQ - 1 : s + R;
    const float inv = 1.0f / (float)(hi - lo + 1);
    u32x4 w; w.x = pg8::cvt_pk_bf16(a[0] * inv - bf_lo(c.x), a[1] * inv - bf_hi(c.x)); w.y = pg8::cvt_pk_bf16(a[2] * inv - bf_lo(c.y), a[3] * inv - bf_hi(c.y));
    w.z = pg8::cvt_pk_bf16(a[4] * inv - bf_lo(c.z), a[5] * inv - bf_hi(c.z)); w.w = pg8::cvt_pk_bf16(a[6] * inv - bf_lo(c.w), a[7] * inv - bf_hi(c.w));
    *(u32x4*)(orow + g * 128 + c16 * 8) = w;
}
__device__ __forceinline__ void pool_load(u32x4 (&v)[6], const bf16_t* Q, int ti, int tid) {
    const int b = ti >> 6, s0 = (ti & 63) * 32;
#pragma unroll
    for (int k = 0; k < 6; ++k) { const int id = tid + 512 * k, row = id >> 6, c = id & 63, s = s0 - 8 + row;
        v[k] = (s >= 0 && s < SEQ) ? *(const u32x4*)(Q + ((size_t)(b * SEQ + s)) * 512 + c * 8) : (u32x4){0u, 0u, 0u, 0u}; }
}
__device__ __forceinline__ int pool_tile_of(int tt) { return (tt & 7) * 128 + (tt >> 3); }
__device__ __forceinline__ void pool_phase(const bf16_t* Q, bf16_t* YC, LAS unsigned char* lds, int G, int c) {
    const int tid = tid_opaque(), lane = tid & 63, wid = tid >> 6;
    const int ntiles = NTOK / 32;
    u32x4 v[6];
    if (c < ntiles) pool_load(v, Q, pool_tile_of(c), tid);
    for (int tt = c; tt < ntiles; tt += G) {
        const int ti = pool_tile_of(tt);
#pragma unroll
        for (int k = 0; k < 6; ++k) *(LAS u32x4*)(lds + (size_t)(tid + 512 * k) * 16) = v[k];
        __syncthreads();
        if (tt + G < ntiles) pool_load(v, Q, pool_tile_of(tt + G), tid);
        const int b = ti >> 6, s0 = (ti & 63) * 32, tl = wid * 4 + (lane >> 4), c16 = lane & 15, s = s0 + tl;
        bf16_t* orow = YC + ((size_t)(b * SEQ + s)) * 1024 + 512;
        pool_group<1>(lds, tl, s, 0, c16, orow); pool_group<2>(lds, tl, s, 1, c16, orow); pool_group<4>(lds, tl, s, 2, c16, orow); pool_group<8>(lds, tl, s, 3, c16, orow);
        __syncthreads();
    }
}

#define XB_TMO      128
#define XB_XCNT(j)  (256  + 64 * (j))
#define XB_XSUB(j)  (1280 + 64 * (j))
#define XB_XGEN(j)  (2304 + 64 * (j))
#define XB_TOP      3328
#define XB_TOPGEN   3392
#define XCD_BAR_WORDS 3456
#define XB_SPIN_CAP (1u << 22)
__device__ __forceinline__ unsigned xb_ld(unsigned* p)              { return __hip_atomic_load(p, __ATOMIC_RELAXED, __HIP_MEMORY_SCOPE_AGENT); }
__device__ __forceinline__ unsigned xb_add(unsigned* p, unsigned v) { return __hip_atomic_fetch_add(p, v, __ATOMIC_RELAXED, __HIP_MEMORY_SCOPE_AGENT); }
__device__ __forceinline__ unsigned xb_xcc_id() { return (unsigned)__builtin_amdgcn_s_getreg((3 << 11) | 20) & 0xFu; }
#define XB_SPIN(cond, bar) do { unsigned _sp = 0; while (cond) { __builtin_amdgcn_s_sleep(1); \
    if ((++_sp & 255u) == 0u) { if (xb_ld(&(bar)[XB_TMO])) break; if (_sp > XB_SPIN_CAP) { atomicAdd(&(bar)[XB_TMO], 1u); break; } } } } while (0)
struct XcdBarrier { unsigned* bar; unsigned x; volatile LAS unsigned* st; };
__device__ __forceinline__ XcdBarrier xcd_barrier_post(unsigned* bar, volatile LAS unsigned* st) {
    XcdBarrier b; b.bar = bar; b.x = xb_xcc_id(); b.st = st;
    if (threadIdx.x == 0) (void)xb_add(&bar[XB_XCNT(b.x)], 1u);
    return b;
}
__device__ __forceinline__ void xcd_barrier_complete(unsigned* bar, unsigned x, unsigned& nloc, unsigned& nx) {
    const unsigned G = gridDim.x * gridDim.y * gridDim.z;
    unsigned sum, cnt, mine, sp = 0u;
    for (;;) {
        sum = 0u; cnt = 0u; mine = 0u;
#pragma unroll
        for (unsigned j = 0; j < 16; ++j) { const unsigned c = xb_ld(&bar[XB_XCNT(j)]); sum += c; cnt += (c > 0u) ? 1u : 0u; mine = (j == x) ? c : mine; }
        if (sum == G) break;
        __builtin_amdgcn_s_sleep(1);
        if ((++sp & 255u) == 0u) { if (xb_ld(&bar[XB_TMO])) break; if (sp > XB_SPIN_CAP) { atomicAdd(&bar[XB_TMO], 1u); break; } }
    }
    nloc = mine > 0u ? mine : 1u; nx = cnt > 0u ? cnt : 1u;
}
__device__ __forceinline__ unsigned xcd_census_uniform(unsigned* bar) {
    if (gridDim.x != 256u) return 0u;
    unsigned ok = 1u;
#pragma unroll
    for (unsigned j = 0; j < 16; ++j) { const unsigned c = xb_ld(&bar[XB_XCNT(j)]); ok &= (j < 8u) ? (c == 32u) : (c == 0u); }
    return ok;
}
__device__ __forceinline__ void xcd_barrier(const XcdBarrier& b) {
    asm volatile("s_waitcnt vmcnt(0)" ::: "memory");
    __syncthreads();
    if (threadIdx.x == 0) {
        unsigned* bar = b.bar;
        __builtin_amdgcn_s_waitcnt(0);
        unsigned nloc = b.st[0], nx = b.st[1];
        if (nloc == 0u) { xcd_barrier_complete(bar, b.x, nloc, nx); b.st[0] = nloc; b.st[1] = nx; b.st[3] = xcd_census_uniform(bar); }
        const unsigned old = xb_add(&bar[XB_XSUB(b.x)], 1u);
        const unsigned gen = old / nloc;
        if (old + 1u == (gen + 1u) * nloc) {
            __builtin_amdgcn_fence(__ATOMIC_RELEASE, "agent");
            asm volatile("s_waitcnt vmcnt(0)" ::: "memory");
            const unsigned og = xb_add(&bar[XB_TOP], 1u);
            const unsigned tg = og / nx;
            if (og + 1u == (tg + 1u) * nx) xb_add(&bar[XB_TOPGEN], 1u);
            else XB_SPIN(xb_ld(&bar[XB_TOPGEN]) == tg, bar);
            __builtin_amdgcn_fence(__ATOMIC_ACQUIRE, "agent");
            xb_add(&bar[XB_XGEN(b.x)], 1u);
            asm volatile("s_waitcnt vmcnt(0)" ::: "memory");
        } else {
            XB_SPIN(xb_ld(&bar[XB_XGEN(b.x)]) == gen, bar);
            __builtin_amdgcn_fence(__ATOMIC_ACQUIRE, "agent");
            asm volatile("s_waitcnt vmcnt(0)" ::: "memory");
        }
    }
    __syncthreads();
}

#define XB_LSUB(j)  (3520 + 64 * (j))
#define XB_LGEN(j)  (4544 + 64 * (j))
__device__ __forceinline__ void xcd_local_barrier(const XcdBarrier& b) {
    asm volatile("s_waitcnt vmcnt(0)" ::: "memory");
    __syncthreads();
    if (threadIdx.x == 0) {
        unsigned* bar = b.bar;
        __builtin_amdgcn_s_waitcnt(0);
        const unsigned old = xb_add(&bar[XB_LSUB(b.x)], 1u);
        const unsigned target = (old / 32u + 1u) * 32u;
        if (old + 1u != target) { unsigned sp = 0u; while (xb_ld(&bar[XB_LSUB(b.x)]) < target) { if (++sp > (1u << 24)) { atomicAdd(&bar[XB_TMO], 1u); break; } } }
        __builtin_amdgcn_fence(__ATOMIC_ACQUIRE, "agent");
        asm volatile("s_waitcnt vmcnt(0)" ::: "memory");
    }
    __syncthreads();
}

constexpr int NPHASES = 2 + NL * 10;
__global__ void __launch_bounds__(NTHREADS, 2) fwd_kernel(Params p) {
    extern __shared__ __attribute__((aligned(16))) unsigned char lds_raw[];
    LAS unsigned char* lds = (LAS unsigned char*)lds_raw;
    cg::grid_group grid = cg::this_grid();
    const int G = gridDim.x;
    volatile LAS unsigned* bst = (volatile LAS unsigned*)(lds + LDS_STAGE);
    if (threadIdx.x == 0) { bst[0] = 0u; bst[1] = 0u; bst[2] = 0u; bst[3] = 0u; }
    __syncthreads();
    XcdBarrier xbar; xbar.bar = (unsigned*)(p.ws + OFF_BAR); xbar.x = xb_xcc_id(); xbar.st = bst;
    if (threadIdx.x == 0) bst[2] = xb_add(&xbar.bar[XB_XCNT(xbar.x)], 1u);
    int vc = (int)blockIdx.x; bool local = false;
    bf16_t* WGU = (bf16_t*)(p.ws + OFF_WGU); bf16_t* WD = (bf16_t*)(p.ws + OFF_WD); bf16_t* WA = (bf16_t*)(p.ws + OFF_WA); bf16_t* WB = (bf16_t*)(p.ws + OFF_WB);
    bf16_t* WO = (bf16_t*)(p.ws + OFF_WO); bf16_t* TM = (bf16_t*)(p.ws + OFF_TM); bf16_t* H = (bf16_t*)(p.ws + OFF_H); bf16_t* Y = (bf16_t*)(p.ws + OFF_Y);
    bf16_t* HID = (bf16_t*)(p.ws + OFF_HID); bf16_t* PT = (bf16_t*)(p.ws + OFF_PT); bf16_t* Q = (bf16_t*)(p.ws + OFF_Q); bf16_t* YC = (bf16_t*)(p.ws + OFF_YCAT);
    bf16_t* HF = (bf16_t*)(p.ws + OFF_HF); float* NYQ = (float*)(p.ws + OFF_NYQ);

    for (int ph = p.ph_lo; ph < p.ph_hi; ++ph) {
        if (ph > p.ph_lo) {
            if (p.ph_hi < 0) grid.sync();
            else if (local && ph > 2) xcd_local_barrier(xbar);
            else xcd_barrier(xbar);
            if (XCD_LOCAL && ph == 2 && p.ph_lo == 0) { local = (__builtin_amdgcn_readfirstlane((int)bst[3]) != 0);
                if (local) { vc = __builtin_amdgcn_readfirstlane((int)bst[2]) * 8 + (int)xbar.x;
                    unsigned char* slice = p.ws + OFF_HID + (size_t)xbar.x * ((size_t)4096 * FF * 2);
                    PT = (bf16_t*)(slice - (size_t)xbar.x * ((size_t)4 << 20));
                    Q = (bf16_t*)(slice + ((size_t)4 << 20) - (size_t)xbar.x * ((size_t)4 << 20));
                    YC = (bf16_t*)(slice + ((size_t)8 << 20) - (size_t)xbar.x * ((size_t)8 << 20)); HF = YC;
                    if (STAGGER_TICKS > 0) { const unsigned long long t0 = __builtin_amdgcn_s_memrealtime(), dl = (unsigned long long)xbar.x * STAGGER_TICKS;
                        while (__builtin_amdgcn_s_memrealtime() - t0 < dl) __builtin_amdgcn_s_sleep(8); } } }
        }
        if (ph == 0) {
            for (int rep = 0; rep < PREP_REPS; ++rep) {
            transpose_phase(p, lds, G);
            tm_phase(p, G);
            mcs_phase(p, lds, G);
            }
            norm_phase(nullptr, p.in[0], nullptr, H, nullptr, nullptr, p.in[1], 0.f, G, (int)blockIdx.x, false, false);
            continue;
        }
        if (ph == 1) { for (int rep = 0; rep < FOLD_REPS; ++rep) fold_phase(p, lds, G); continue; }
        const int l = (ph - 2) / 10, s = (ph - 2) % 10;
        if (s == 0 || s == 7) {
            const int f = (s == 7);
            pg8::Gemm g{H, WGU + (size_t)(l * 2 + f) * 5632 * 1024, NTOK, 5632, 1024, 0};
            pg8::Order S; S.init(NTOK, 5632, G, vc, 0, G1_WGM);
            pg8::EpiSwiGLU E{HID, 0};
            for (int rep = 0; rep < GEMM_REPS; ++rep) { E.dry = (rep > 0 && p.ph_lo >= 0); pg8::gemm_phase<pg8::EpiSwiGLU, pg8::Order, true, true>(lds, g, S, E); }
        } else if (s == 2 || s == 6 || s == 9) {
            const float* gpost = (s == 2 ? p.in[5] : s == 6 ? p.in[12] : p.in[17]) + (size_t)l * DM;
            const float* gpre = (s == 2 ? p.in[6] + (size_t)l * DM : s == 6 ? p.in[13] + (size_t)l * DM : p.in[1] + (size_t)(l + 1) * DM);
            const bool fin = (s == 9 && l == NL - 1);
            norm_phase(Y, (l == 0 && s == 2) ? p.in[0] : p.out, p.out, fin ? nullptr : H, s == 2 ? HF : nullptr, gpost, gpre, s == 6 ? 1.0f : 0.5f, G, vc, !(l == 0 && s == 2), !fin);
        } else {
            const int nsub = (s == 3) ? 2 : 1;
            if (s == 3) nyq_phase(WA + (size_t)l * 1024 * 1024, H, NYQ, G, vc);
            for (int sub = 0; sub < nsub; ++sub) {
                pg8::Gemm g; pg8::Order S; pg8::EpiMap E;
                if (s == 1 || s == 8) { const int f = (s == 8); g = pg8::Gemm{HID, WD + (size_t)(l * 2 + f) * 1024 * 2816, NTOK, 1024, 2816, 1}; S.init(NTOK, 1024, G, vc, 0); E = pg8::EpiMap{Y, 1024, 0, 0, nullptr}; }
                else if (s == 3 && sub == 0) { g = pg8::Gemm{WA + (size_t)l * 1024 * 1024, HF, 1024, NTOK, 1024, 0}; S.init(1024, NTOK, G, vc, 2); E = pg8::EpiMap{PT, 2048, 1, 0, nullptr}; }
                else if (s == 3) { g = pg8::Gemm{H, WB + (size_t)l * 512 * 1024, NTOK, 512, 1024, 0}; S.init(NTOK, 512, G, vc, 0); E = pg8::EpiMap{Q, 512, 0, 0, nullptr}; }
                else if (s == 4) { g = pg8::Gemm{TM, PT, 2048, 8192, 2048, 0}; S.init(2048, 8192, G, vc, 1); E = pg8::EpiMap{YC, 1024, 2, 0, NYQ}; }
                else { g = pg8::Gemm{YC, WO + (size_t)l * 1024 * 1024, NTOK, 1024, 1024, 0}; S.init(NTOK, 1024, G, vc, 0); E = pg8::EpiMap{Y, 1024, 0, 0, nullptr}; }
                for (int rep = 0; rep < GEMM_REPS; ++rep) { E.dry = (rep > 0 && p.ph_lo >= 0); pg8::gemm_phase<pg8::EpiMap, pg8::Order, true, true>(lds, g, S, E); }
            }
            if (s == 4) for (int rep = 0; rep < POOL_REPS; ++rep) pool_phase(Q, YC, lds, G, vc);
        }
    }
}

extern "C" void kernel_launch(void* const* d_in, const int* in_sizes, int n_in, void* d_out, int out_size, void* d_ws, size_t ws_size, hipStream_t stream) {
    static int grid = 0;
    if (grid == 0) {
        if (n_in != 18 || out_size != NTOK * DM || ws_size < WS_END) { fprintf(stderr, "kernel_launch: unexpected shapes (n_in %d out %d ws %zu need %zu)\n", n_in, out_size, ws_size, (size_t)WS_END); grid = -1; return; }
        int dev = 0, cus = 0, per_cu = 0;
        hipGetDevice(&dev); hipDeviceGetAttribute(&cus, hipDeviceAttributeMultiprocessorCount, dev);
        if (hipFuncSetAttribute((const void*)fwd_kernel, hipFuncAttributeMaxDynamicSharedMemorySize, LDS_BYTES) != hipSuccess) { fprintf(stderr, "kernel_launch: hipFuncSetAttribute failed\n"); grid = -1; return; }
        if (hipOccupancyMaxActiveBlocksPerMultiprocessor(&per_cu, (const void*)fwd_kernel, NTHREADS, LDS_BYTES) != hipSuccess || per_cu < 1) { fprintf(stderr, "kernel_launch: occupancy query says %d\n", per_cu); per_cu = 1; }
        (void)hipGetLastError();
        grid = cus * per_cu;
        fprintf(stderr, "kernel_launch: grid %d (cus %d x %d)\n", grid, cus, per_cu);
    }
    if (grid < 0) return;
    if (hipMemsetAsync((char*)d_ws + OFF_BAR, 0, SZ_BAR, stream) != hipSuccess) { fprintf(stderr, "kernel_launch: memset failed\n"); return; }
    Params p{};
    for (int i = 0; i < 18; ++i) p.in[i] = (const float*)d_in[i];
    p.out = (float*)d_out; p.ws = (unsigned char*)d_ws;
#if MULTI_LAUNCH
    for (int ph = 0; ph < NPHASES; ++ph) { p.ph_lo = ph; p.ph_hi = ph + 1; hipLaunchKernelGGL(fwd_kernel, dim3(grid), dim3(NTHREADS), LDS_BYTES, stream, p); }
#else
    p.ph_lo = 0; p.ph_hi = NPHASES;
    void* args[] = {&p};
    hipError_t e = hipLaunchCooperativeKernel((const void*)fwd_kernel, dim3(grid), dim3(NTHREADS), args, LDS_BYTES, stream);
    if (e != hipSuccess) fprintf(stderr, "kernel_launch: cooperative launch failed: %s (grid %d)\n", hipGetErrorString(e), grid);
#endif
}
```
